# Optimizing an MI355X kernel written in HIP

```python
import math
import jax, jax.numpy as jnp
from jax import lax
import numpy as np

D_MODEL = 2048
BATCH = 4
SEQ = 8192
DEPTH = 1
DEC_BATCH = 2
DEC_SEQ = 4096
PAST_LEN = 128

MIX_WIDTH = D_MODEL
FOURIER_WIDTH = MIX_WIDTH // 2
ATTN_WIDTH = MIX_WIDTH - FOURIER_WIDTH
N_FOURIER_GROUPS = 8
FOURIER_GROUP_DIM = FOURIER_WIDTH // N_FOURIER_GROUPS
N_DIFF_HEADS = 8
DIFF_V_DIM = ATTN_WIDTH // N_DIFF_HEADS
DIFF_QK_DIM = DIFF_V_DIM // 2
IN_PROJ_COLS = FOURIER_WIDTH + 3 * ATTN_WIDTH
N_MEM = 256
N_CROSS_HEADS = 4
CROSS_HEAD_DIM = D_MODEL // N_CROSS_HEADS
D_FF = -(-8 * D_MODEL // (3 * 256)) * 256
ROPE_THETA = 10000.0
Q_BLOCK = 128
EPS = 1e-6
SUBLN_EPS = 1e-5

kernel_name = "hybrid_fourier_diffattn_encoder"


def rmsnorm(x, g, eps=EPS):
    xf = x.astype(jnp.float32)
    y = xf * lax.rsqrt(jnp.mean(xf * xf, axis=-1, keepdims=True) + eps)
    return (y * g.astype(jnp.float32)).astype(x.dtype)


def rope_tables(seq, dim):
    inv = 1.0 / (ROPE_THETA ** (jnp.arange(0, dim, 2, dtype=jnp.float32) / dim))
    ang = jnp.arange(seq, dtype=jnp.float32)[:, None] * inv[None, :]
    ang = jnp.concatenate([ang, ang], axis=-1)
    return jnp.cos(ang), jnp.sin(ang)


def apply_rope(t, cos, sin):
    half = t.shape[-1] // 2
    tf = t.astype(jnp.float32)
    rot = jnp.concatenate([-tf[..., half:], tf[..., :half]], axis=-1)
    c = cos[None, :, None, None, :]
    s = sin[None, :, None, None, :]
    return (tf * c + rot * s).astype(t.dtype)


def fourier_mix(u, w_f):
    B, S, _ = u.shape
    ug = u.reshape(B, S, N_FOURIER_GROUPS, FOURIER_GROUP_DIM).astype(jnp.float32)
    f = jnp.fft.fft2(ug, axes=(1, 3), norm="ortho").real.astype(u.dtype)
    y = jnp.einsum("bsgc,gcd->bsgd", f, w_f)
    return y.reshape(B, S, FOURIER_WIDTH)


def diff_attention(q, k, v, lam):
    B, S, H, _, dh = q.shape
    nblk = S // Q_BLOCK
    qb = q.reshape(B, nblk, Q_BLOCK, H, 2, dh).transpose(1, 0, 2, 3, 4, 5)
    scale = dh ** -0.5

    def block(qi):
        s = jnp.einsum("bqhcd,bkhcd->bhcqk", qi, k, preferred_element_type=jnp.float32) * scale
        p = jax.nn.softmax(s, axis=-1)
        a = p[:, :, 0] - lam * p[:, :, 1]
        return jnp.einsum("bhqk,bkhe->bqhe", a.astype(v.dtype), v)

    ob = lax.map(block, qb)
    return ob.transpose(1, 0, 2, 3, 4).reshape(B, S, H, v.shape[-1])


def cross_attention(h, mem_n, w_cq, w_ck, w_cv, w_co):
    B, S, _ = h.shape
    M = mem_n.shape[1]
    q = (h @ w_cq).reshape(B, S, N_CROSS_HEADS, CROSS_HEAD_DIM)
    k = (mem_n @ w_ck).reshape(B, M, N_CROSS_HEADS, CROSS_HEAD_DIM)
    v = (mem_n @ w_cv).reshape(B, M, N_CROSS_HEADS, CROSS_HEAD_DIM)
    s = jnp.einsum("bqhd,bkhd->bhqk", q, k, preferred_element_type=jnp.float32) * (CROSS_HEAD_DIM ** -0.5)
    p = jax.nn.softmax(s, axis=-1).astype(v.dtype)
    o = jnp.einsum("bhqk,bkhd->bqhd", p, v).reshape(B, S, D_MODEL)
    return o @ w_co


def encoder_layer(x, mem, l, g_mix, w_in, w_fourier, lambda_q1, lambda_k1, lambda_q2, lambda_k2,
                  g_subln, w_out, g_cross, g_mem, w_cq, w_ck, w_cv, w_co, g_ffn, w_gate, w_up, w_down):
    B, S, _ = x.shape
    lam_init = 0.8 - 0.6 * math.exp(-0.3 * l)
    h = rmsnorm(x, g_mix)
    proj = h @ w_in
    u_f = proj[..., :FOURIER_WIDTH]
    q = proj[..., FOURIER_WIDTH:FOURIER_WIDTH + ATTN_WIDTH].reshape(B, S, N_DIFF_HEADS, 2, DIFF_QK_DIM)
    k = proj[..., FOURIER_WIDTH + ATTN_WIDTH:FOURIER_WIDTH + 2 * ATTN_WIDTH].reshape(B, S, N_DIFF_HEADS, 2, DIFF_QK_DIM)
    v = proj[..., FOURIER_WIDTH + 2 * ATTN_WIDTH:].reshape(B, S, N_DIFF_HEADS, DIFF_V_DIM)

    y_f = fourier_mix(u_f, w_fourier)

    cos, sin = rope_tables(S, DIFF_QK_DIM)
    q = apply_rope(q, cos, sin)
    k = apply_rope(k, cos, sin)
    lq1 = lambda_q1.astype(jnp.float32); lk1 = lambda_k1.astype(jnp.float32)
    lq2 = lambda_q2.astype(jnp.float32); lk2 = lambda_k2.astype(jnp.float32)
    lam = jnp.exp(jnp.sum(lq1 * lk1)) - jnp.exp(jnp.sum(lq2 * lk2)) + lam_init
    o = diff_attention(q, k, v, lam)
    o = rmsnorm(o, g_subln, SUBLN_EPS) * (1.0 - lam_init)
    mix = jnp.concatenate([y_f, o.reshape(B, S, ATTN_WIDTH).astype(y_f.dtype)], axis=-1) @ w_out
    x = x + mix
    x = x + cross_attention(rmsnorm(x, g_cross), rmsnorm(mem, g_mem), w_cq, w_ck, w_cv, w_co)
    hf = rmsnorm(x, g_ffn)
    x = x + (jax.nn.silu(hf @ w_gate) * (hf @ w_up)) @ w_down
    return x


def setup_inputs(seed: int = 0) -> dict:
    key = jax.random.key(seed)
    ks = jax.random.split(key, 24)
    f32 = jnp.float32

    def w(k, shape, fan_in):
        return jax.random.normal(k, shape, f32) * (fan_in ** -0.5)

    def gain(k, shape):
        return 1.0 + 0.02 * jax.random.normal(k, shape, f32)

    return {
        "x_prompt": jax.random.normal(ks[0], (BATCH, SEQ, D_MODEL), f32),
        "x_sample": jax.random.normal(ks[1], (DEC_BATCH, DEC_SEQ, D_MODEL), f32),
        "mem_prompt": jax.random.normal(ks[2], (BATCH, N_MEM, D_MODEL), f32),
        "mem_sample": jax.random.normal(ks[3], (DEC_BATCH, N_MEM, D_MODEL), f32),
        "g_mix": gain(ks[4], (DEPTH, D_MODEL)),
        "w_in": w(ks[5], (DEPTH, D_MODEL, IN_PROJ_COLS), D_MODEL),
        "w_fourier": w(ks[6], (DEPTH, N_FOURIER_GROUPS, FOURIER_GROUP_DIM, FOURIER_GROUP_DIM), FOURIER_GROUP_DIM),
        "lambda_q1": 0.1 * jax.random.normal(ks[7], (DEPTH, DIFF_QK_DIM), f32),
        "lambda_k1": 0.1 * jax.random.normal(ks[8], (DEPTH, DIFF_QK_DIM), f32),
        "lambda_q2": 0.1 * jax.random.normal(ks[9], (DEPTH, DIFF_QK_DIM), f32),
        "lambda_k2": 0.1 * jax.random.normal(ks[10], (DEPTH, DIFF_QK_DIM), f32),
        "g_subln": gain(ks[11], (DEPTH, DIFF_V_DIM)),
        "w_out": w(ks[12], (DEPTH, MIX_WIDTH, D_MODEL), MIX_WIDTH),
        "g_cross": gain(ks[13], (DEPTH, D_MODEL)),
        "g_mem": gain(ks[14], (DEPTH, D_MODEL)),
        "w_cq": w(ks[15], (DEPTH, D_MODEL, D_MODEL), D_MODEL),
        "w_ck": w(ks[16], (DEPTH, D_MODEL, D_MODEL), D_MODEL),
        "w_cv": w(ks[17], (DEPTH, D_MODEL, D_MODEL), D_MODEL),
        "w_co": w(ks[18], (DEPTH, D_MODEL, D_MODEL), D_MODEL),
        "g_ffn": gain(ks[19], (DEPTH, D_MODEL)),
        "w_gate": w(ks[20], (DEPTH, D_MODEL, D_FF), D_MODEL),
        "w_up": w(ks[21], (DEPTH, D_MODEL, D_FF), D_MODEL),
        "w_down": w(ks[22], (DEPTH, D_FF, D_MODEL), D_FF),
        "g_final": gain(ks[23], (D_MODEL,)),
    }


def _trunk(x, mem, g_mix, w_in, w_fourier, lambda_q1, lambda_k1, lambda_q2, lambda_k2, g_subln, w_out,
           g_cross, g_mem, w_cq, w_ck, w_cv, w_co, g_ffn, w_gate, w_up, w_down, g_final):
    for l in range(DEPTH):
        x = encoder_layer(x, mem, l, g_mix[l], w_in[l], w_fourier[l], lambda_q1[l], lambda_k1[l],
                          lambda_q2[l], lambda_k2[l], g_subln[l], w_out[l], g_cross[l], g_mem[l],
                          w_cq[l], w_ck[l], w_cv[l], w_co[l], g_ffn[l], w_gate[l], w_up[l], w_down[l])
    return rmsnorm(x, g_final)


def reference(x_prompt, x_sample, mem_prompt, mem_sample, g_mix, w_in, w_fourier, lambda_q1, lambda_k1,
              lambda_q2, lambda_k2, g_subln, w_out, g_cross, g_mem, w_cq, w_ck, w_cv, w_co, g_ffn,
              w_gate, w_up, w_down, g_final):
    y_prompt = _trunk(x_prompt, mem_prompt, g_mix, w_in, w_fourier, lambda_q1, lambda_k1, lambda_q2, lambda_k2,
                      g_subln, w_out, g_cross, g_mem, w_cq, w_ck, w_cv, w_co, g_ffn, w_gate, w_up, w_down, g_final)
    y_sample = _trunk(x_sample, mem_sample, g_mix, w_in, w_fourier, lambda_q1, lambda_k1, lambda_q2, lambda_k2,
                      g_subln, w_out, g_cross, g_mem, w_cq, w_ck, w_cv, w_co, g_ffn, w_gate, w_up, w_down, g_final)
    return (y_prompt, y_sample)
```

```cpp
#include <hip/hip_runtime.h>
#include <hip/hip_cooperative_groups.h>
#include <cstdio>
#include <cstdint>
namespace cg = cooperative_groups;

#ifndef PHMASK
#define PHMASK 0x1FFF
#endif
#ifndef ONE_LAUNCH
#define ONE_LAUNCH 1
#endif

#define LAS __attribute__((address_space(3)))
typedef unsigned short bf16_t;
typedef short bf16x8 __attribute__((ext_vector_type(8)));
typedef short s16x4 __attribute__((ext_vector_type(4)));
typedef float f32x4 __attribute__((ext_vector_type(4)));
typedef float f32x16 __attribute__((ext_vector_type(16)));
typedef unsigned u32x4 __attribute__((ext_vector_type(4)));
typedef unsigned u32x2 __attribute__((ext_vector_type(2)));

constexpr int DM = 2048, T_P = 32768, T_ALL = 40960, NPROJ = 5120, DFF = 5632, NMEMROWS = 1536;
constexpr float EPS = 1e-6f;
constexpr int NPHASE = 12;
constexpr int LDS_BYTES = 131072 + 8192;

constexpr size_t al256(size_t x) { return (x + 255) / 256 * 256; }
constexpr size_t WS_SUMSQ = 0;
constexpr size_t WS_ROPE = al256(WS_SUMSQ + 3ull * T_ALL * 4);
constexpr size_t WS_FMA = al256(WS_ROPE + 8192ull * 32 * 8);
constexpr size_t WS_FMC128 = al256(WS_FMA + 128 * 128 * 2);
constexpr size_t WS_FMC64 = al256(WS_FMC128 + 128 * 256 * 2);
constexpr size_t WS_MEMN = al256(WS_FMC64 + 64 * 128 * 2);
constexpr size_t WS_KMEM = al256(WS_MEMN + (size_t)NMEMROWS * DM * 2);
constexpr size_t WS_VMEMT = al256(WS_KMEM + (size_t)NMEMROWS * DM * 2);
constexpr size_t WS_WIN = al256(WS_VMEMT + (size_t)NMEMROWS * DM * 2);
constexpr size_t WS_WOUT = al256(WS_WIN + (size_t)NPROJ * DM * 2);
constexpr size_t WS_WCQ = al256(WS_WOUT + (size_t)DM * DM * 2);
constexpr size_t WS_WCK = al256(WS_WCQ + (size_t)DM * DM * 2);
constexpr size_t WS_WCV = al256(WS_WCK + (size_t)DM * DM * 2);
constexpr size_t WS_WCO = al256(WS_WCV + (size_t)DM * DM * 2);
constexpr size_t WS_WGU = al256(WS_WCO + (size_t)DM * DM * 2);
constexpr size_t WS_WD = al256(WS_WGU + 2ull * DFF * DM * 2);
constexpr size_t WS_A = al256(WS_WD + (size_t)DM * DFF * 2);
constexpr size_t WS_C = al256(WS_A + (size_t)T_ALL * NPROJ * 2);
constexpr size_t WS_B = al256(WS_C + (size_t)T_ALL * DM * 2);
constexpr size_t WS_END = WS_B + (size_t)T_ALL * DM * 2;
static_assert(WS_END <= (1ull << 30), "workspace");
static_assert((size_t)T_ALL * DFF * 2 <= (WS_B - WS_A), "HFF fits A+C");

struct Params {
    const float *x_p, *x_s, *mem_p, *mem_s, *g_mix, *w_in, *w_f, *lq1, *lk1, *lq2, *lk2, *g_subln, *w_out, *g_cross, *g_mem, *w_cq, *w_ck, *w_cv, *w_co,
        *g_ffn, *w_gate, *w_up, *w_down, *g_final;
    float* out; unsigned char* ws; int ph_lo, ph_hi;
};

__device__ __forceinline__ unsigned cvt_pk_bf16(float lo, float hi) { unsigned r; asm volatile("v_cvt_pk_bf16_f32 %0, %1, %2" : "=v"(r) : "v"(lo), "v"(hi)); return r; }
__device__ __forceinline__ bf16_t f2bf(float f) { return (bf16_t)(cvt_pk_bf16(f, 0.f) & 0xffffu); }
__device__ __forceinline__ float wave_sum(float v) {
#pragma unroll
    for (int o = 1; o < 64; o <<= 1) v += __shfl_xor(v, o);
    return v;
}
__device__ __forceinline__ int opaque_tid() { int t = threadIdx.x; asm volatile("" : "+v"(t)); return t; }
__device__ __forceinline__ int tok0_of(int gb) { return gb < 4 ? gb * 8192 : 32768 + (gb - 4) * 4096; }
__device__ __forceinline__ int crow(int r, int hi) { return (r & 3) + 8 * (r >> 2) + 4 * hi; }

namespace pg8 {
constexpr int BM = 256, BK = 64, HALF = 128, HTB = HALF * BK * 2, STAGE_BYTES = 8 * HTB, NXCD = 8, WGM = 8;
__device__ __forceinline__ int lds_byte(int r, int c) { const int st = (r >> 4) * 2 + (c >> 5), rr = r & 15, cc = c & 31, ob = rr * 64 + cc * 2; return st * 1024 + (ob ^ (((ob >> 9) & 1) << 5)); }
__device__ __forceinline__ void stage_rc(int b, int& R, int& C) { const int st = b / 1024, sb = b % 1024, swz = sb ^ (((sb >> 9) & 1) << 5); R = (st >> 1) * 16 + swz / 64; C = (st & 1) * 32 + (swz % 64) / 2; }
__device__ __forceinline__ int perm32(int rho) { const int n = rho >> 4, i = rho & 15; return 8 * (i >> 2) + 4 * n + (i & 3); }
struct Unit { const char* a; const char* b; int pm, pn; };

struct PlainSched {
    const char* A; const char* B; int nM, nN, nwg, G, c; long tsA, tsB;
    __device__ void init(const void* A_, const void* B_, int M, int N, int lda, int ldb) {
        A = (const char*)A_; B = (const char*)B_; nM = M / BM; nN = N / BM; nwg = nM * nN; G = gridDim.x; c = blockIdx.x; tsA = (long)BM * lda * 2; tsB = (long)BM * ldb * 2; }
    __device__ __forceinline__ bool next(int i, Unit& u) const {
        const long L = (long)i * G + c; if (L >= nwg) return false;
        int wgid = (int)L; { const int q = nwg / NXCD, r = nwg % NXCD, xcd = wgid % NXCD, off = wgid / NXCD; wgid = (xcd < r ? xcd * (q + 1) : r * (q + 1) + (xcd - r) * q) + off; }
        const int nig = WGM * nN, gid = wgid / nig, fm = gid * WGM, gsz = (nM - fm) < WGM ? (nM - fm) : WGM;
        u.pm = fm + ((wgid % nig) % gsz); u.pn = (wgid % nig) / gsz;
        u.a = A + (long)u.pm * tsA; u.b = B + (long)u.pn * tsB; return true;
    }
};

template <class Epi, class Sched>
__device__ __forceinline__ void gemm_phase(LAS unsigned char* lds, const int K, const int lda, const int ldb, const Sched& S, const Epi& E) {
    const int tid = opaque_tid(), wid = __builtin_amdgcn_readfirstlane(tid >> 6), lane = tid & 63, wr = wid >> 2, wc = wid & 3, fr = lane & 15, fq = lane >> 4;
    const int nt = K / BK;
    unsigned voffA[2], voffB[2];
#pragma unroll
    for (int i = 0; i < 2; ++i) { int R, C; stage_rc(tid * 16 + i * 8192, R, C); const int Rb = Epi::PERM ? ((R & ~31) + perm32(R & 31)) : R;
        voffA[i] = (unsigned)(R * lda + C) * 2u; voffB[i] = (unsigned)(Rb * ldb + C) * 2u; }
    const size_t kstep = (size_t)(BK * 2);
    const size_t hstepA = (size_t)HALF * lda * 2, hstepB = (size_t)HALF * ldb * 2;
    const unsigned ldsw = (unsigned)wid * 1024u;
    const int aoff = lds_byte(wr * 64 + fr, fq * 8), boff = lds_byte(wc * 32 + fr, fq * 8);
#define PG8_SA(b, h) (((b) * 2 + (h)) * HTB)
#define PG8_SB(b, h) ((4 + (b) * 2 + (h)) * HTB)
#define PG8_STAGE(bufoff, gbase, voff) do { _Pragma("unroll") for (int _i = 0; _i < 2; ++_i) \
        __builtin_amdgcn_global_load_lds((const unsigned*)((const char*)(gbase) + (voff)[_i]), (LAS unsigned*)(lds + (bufoff) + ldsw + _i * 8192), 16, 0, 0); } while (0)
#define PG8_LDA(dst, b, h) do { _Pragma("unroll") for (int m = 0; m < 4; ++m) _Pragma("unroll") for (int k = 0; k < 2; ++k) dst[m][k] = *(const LAS bf16x8*)(lds + PG8_SA(b, h) + aoff + m * 2048 + k * 1024); } while (0)
#define PG8_LDB(dst, b, h) do { _Pragma("unroll") for (int n = 0; n < 2; ++n) _Pragma("unroll") for (int k = 0; k < 2; ++k) dst[n][k] = *(const LAS bf16x8*)(lds + PG8_SB(b, h) + boff + n * 2048 + k * 1024); } while (0)
#define PG8_MMA(ai, bj, At, Bt) do { __builtin_amdgcn_s_setprio(1); _Pragma("unroll") for (int m = 0; m < 4; ++m) _Pragma("unroll") for (int n = 0; n < 2; ++n) _Pragma("unroll") for (int k = 0; k < 2; ++k) \
        acc[ai][bj][m][n] = __builtin_amdgcn_mfma_f32_16x16x32_bf16(Bt[n][k], At[m][k], acc[ai][bj][m][n], 0, 0, 0); __builtin_amdgcn_s_setprio(0); } while (0)
#define PG8_WAIT_V(n) asm volatile("s_waitcnt vmcnt(" #n ")" ::: "memory")
#define PG8_WAIT_L(n) asm volatile("s_waitcnt lgkmcnt(" #n ")" ::: "memory")
#define PG8_BAR __builtin_amdgcn_s_barrier()
#define PG8_SCHED __builtin_amdgcn_sched_barrier(0)
    Unit cur, nxt; int ui = 0;
    if (!S.next(0, cur)) return;
    f32x4 acc[2][2][4][2];
#pragma unroll
    for (int a = 0; a < 2; ++a)
#pragma unroll
        for (int b = 0; b < 2; ++b)
#pragma unroll
            for (int m = 0; m < 4; ++m)
#pragma unroll
                for (int n = 0; n < 2; ++n) acc[a][b][m][n] = (f32x4){0.f, 0.f, 0.f, 0.f};
    bf16x8 At[4][2], B0[2][2], B1[2][2];
    const char* cA = cur.a; const char* cB = cur.b;
    PG8_STAGE(PG8_SB(0, 0), cB, voffB); PG8_STAGE(PG8_SA(0, 0), cA, voffA); PG8_STAGE(PG8_SB(0, 1), cB + hstepB, voffB); PG8_STAGE(PG8_SA(0, 1), cA + hstepA, voffA);
    if (wr == 1) PG8_BAR;
    PG8_WAIT_V(4); PG8_BAR;
    PG8_STAGE(PG8_SB(1, 0), cB + kstep, voffB); PG8_STAGE(PG8_SA(1, 0), cA + kstep, voffA); PG8_STAGE(PG8_SB(1, 1), cB + hstepB + kstep, voffB);
    PG8_WAIT_V(6); PG8_BAR;
    for (;;) {
        const bool has_next = S.next(ui + 1, nxt);
        const char* nA = has_next ? nxt.a : cA; const char* nB = has_next ? nxt.b : cB;
#pragma unroll 1
        for (int t = 0; t < nt; t += 2) {
            const bool last = (t == nt - 2);
            const char* a1 = cA + (size_t)(t + 1) * kstep;
            const char* a2 = last ? nA : cA + (size_t)(t + 2) * kstep; const char* b2 = last ? nB : cB + (size_t)(t + 2) * kstep;
            const char* a3 = a2 + kstep; const char* b3 = b2 + kstep;
            PG8_LDB(B0, 0, 0); PG8_SCHED; PG8_LDA(At, 0, 0); PG8_STAGE(PG8_SA(1, 1), a1 + hstepA, voffA);
            PG8_WAIT_L(8); PG8_BAR; PG8_WAIT_L(0); PG8_MMA(0, 0, At, B0); PG8_BAR; PG8_SCHED;
            PG8_LDB(B1, 0, 1); PG8_STAGE(PG8_SB(0, 0), b2, voffB);
            PG8_BAR; PG8_WAIT_L(0); PG8_MMA(0, 1, At, B1); PG8_BAR;
            PG8_LDA(At, 0, 1); PG8_STAGE(PG8_SA(0, 0), a2, voffA);
            PG8_BAR; PG8_WAIT_L(0); PG8_MMA(1, 0, At, B0); PG8_BAR; PG8_SCHED;
            PG8_STAGE(PG8_SB(0, 1), b2 + hstepB, voffB);
            PG8_WAIT_V(6); PG8_BAR; PG8_MMA(1, 1, At, B1); PG8_BAR;
            PG8_LDB(B0, 1, 0); PG8_SCHED; PG8_LDA(At, 1, 0); PG8_STAGE(PG8_SA(0, 1), a2 + hstepA, voffA);
            PG8_WAIT_L(8); PG8_BAR; PG8_WAIT_L(0); PG8_MMA(0, 0, At, B0); PG8_BAR; PG8_SCHED;
            PG8_LDB(B1, 1, 1); PG8_STAGE(PG8_SB(1, 0), b3, voffB);
            PG8_BAR; PG8_WAIT_L(0); PG8_MMA(0, 1, At, B1); PG8_BAR;
            PG8_LDA(At, 1, 1); PG8_STAGE(PG8_SA(1, 0), a3, voffA);
            PG8_BAR; PG8_WAIT_L(0); PG8_MMA(1, 0, At, B0); PG8_BAR; PG8_SCHED;
            PG8_STAGE(PG8_SB(1, 1), b3 + hstepB, voffB);
            PG8_WAIT_V(6); PG8_BAR; PG8_MMA(1, 1, At, B1); PG8_BAR;
        }
        E(acc, cur, wr, wc, fr, fq);
        if (!has_next) break;
#pragma unroll
        for (int a = 0; a < 2; ++a)
#pragma unroll
            for (int b = 0; b < 2; ++b)
#pragma unroll
                for (int m = 0; m < 4; ++m)
#pragma unroll
                    for (int n = 0; n < 2; ++n) acc[a][b][m][n] = (f32x4){0.f, 0.f, 0.f, 0.f};
        cur = nxt; cA = nA; cB = nB; ++ui;
    }
    PG8_WAIT_V(0);
    if (wr == 0) PG8_BAR;
    PG8_BAR;
#undef PG8_SA
#undef PG8_SB
#undef PG8_STAGE
#undef PG8_LDA
#undef PG8_LDB
#undef PG8_MMA
#undef PG8_WAIT_V
#undef PG8_WAIT_L
#undef PG8_BAR
#undef PG8_SCHED
}
}
using pg8::Unit;
typedef f32x4 (&AccRef)[2][2][4][2];

struct EpiProj {
    static constexpr bool PERM = true;
    bf16_t* O; const float* rope;
    __device__ __forceinline__ void operator()(AccRef acc, const Unit& u, int wr, int wc, int fr, int fq) const {
        const bool rp = (u.pn >= 8 && u.pn < 16);
#pragma unroll
        for (int ai = 0; ai < 2; ++ai)
#pragma unroll
            for (int m = 0; m < 4; ++m) {
                const int row = u.pm * 256 + ai * 128 + wr * 64 + m * 16 + fr;
                const int pos = row < T_P ? (row & 8191) : (row & 4095);
                const unsigned ro = (unsigned)row * NPROJ + u.pn * 256 + wc * 32 + fq * 8;
#pragma unroll
                for (int bj = 0; bj < 2; ++bj) {
                    f32x4 v0 = acc[ai][bj][m][0], v1 = acc[ai][bj][m][1];
                    if (rp) {
                        const unsigned i0 = ((wc * 32 + fq * 8) & 63) >> 1;
                        const unsigned rto = ((unsigned)pos * 32 + i0) * 2;
                        const f32x4 r0 = *(const f32x4*)(rope + rto), r1 = *(const f32x4*)(rope + rto + 4);
                        float a, b;
                        a = v0[0] * r0[0] - v0[1] * r0[1]; b = v0[1] * r0[0] + v0[0] * r0[1]; v0[0] = a; v0[1] = b;
                        a = v0[2] * r0[2] - v0[3] * r0[3]; b = v0[3] * r0[2] + v0[2] * r0[3]; v0[2] = a; v0[3] = b;
                        a = v1[0] * r1[0] - v1[1] * r1[1]; b = v1[1] * r1[0] + v1[0] * r1[1]; v1[0] = a; v1[1] = b;
                        a = v1[2] * r1[2] - v1[3] * r1[3]; b = v1[3] * r1[2] + v1[2] * r1[3]; v1[2] = a; v1[3] = b;
                    }
                    u32x4 w = {cvt_pk_bf16(v0[0], v0[1]), cvt_pk_bf16(v0[2], v0[3]), cvt_pk_bf16(v1[0], v1[1]), cvt_pk_bf16(v1[2], v1[3])};
                    *(u32x4*)(O + ro + bj * 128) = w;
                }
                __builtin_amdgcn_sched_barrier(0);
            }
    }
};
struct EpiStore {
    static constexpr bool PERM = true;
    bf16_t* O; int ldc; long pn_stride; int col_per_pn; const float* sumsq;
    __device__ __forceinline__ void operator()(AccRef acc, const Unit& u, int wr, int wc, int fr, int fq) const {
        bf16_t* base = O + (size_t)u.pn * pn_stride + u.pn * col_per_pn;
#pragma unroll
        for (int ai = 0; ai < 2; ++ai)
#pragma unroll
            for (int m = 0; m < 4; ++m) {
                const int row = u.pm * 256 + ai * 128 + wr * 64 + m * 16 + fr;
                float rs = 1.f;
                if (sumsq) rs = rsqrtf(sumsq[row] * (1.f / DM) + EPS);
                const unsigned ro = (unsigned)row * (unsigned)ldc + wc * 32 + fq * 8;
#pragma unroll
                for (int bj = 0; bj < 2; ++bj) {
                    const f32x4 v0 = acc[ai][bj][m][0] * rs, v1 = acc[ai][bj][m][1] * rs;
                    u32x4 w = {cvt_pk_bf16(v0[0], v0[1]), cvt_pk_bf16(v0[2], v0[3]), cvt_pk_bf16(v1[0], v1[1]), cvt_pk_bf16(v1[2], v1[3])};
                    *(u32x4*)(base + ro + bj * 128) = w;
                }
                __builtin_amdgcn_sched_barrier(0);
            }
    }
};
struct EpiRes {
    static constexpr bool PERM = false;
    const float* X0; const float* X1; float* OUT; bf16_t* XB; float* sumsq;
    __device__ __forceinline__ void operator()(AccRef acc, const Unit& u, int wr, int wc, int fr, int fq) const {
#pragma unroll
        for (int ai = 0; ai < 2; ++ai)
#pragma unroll
            for (int m = 0; m < 4; ++m) {
                const int row = u.pm * 256 + ai * 128 + wr * 64 + m * 16 + fr;
                const float* xb_ = (u.pm < T_P / 256) ? X0 : X1 - (size_t)T_P * DM;
                const unsigned o = (unsigned)row * DM + u.pn * 256 + wc * 32 + fq * 4;
                const float* xr = xb_ + o;
                float ss = 0.f;
#pragma unroll
                for (int bj = 0; bj < 2; ++bj)
#pragma unroll
                    for (int n = 0; n < 2; ++n) {
                        const f32x4 v = *(const f32x4*)(xr + bj * 128 + n * 16) + acc[ai][bj][m][n];
                        *(f32x4*)(OUT + o + bj * 128 + n * 16) = v;
                        if (XB) { u32x2 w = {cvt_pk_bf16(v[0], v[1]), cvt_pk_bf16(v[2], v[3])}; *(u32x2*)(XB + o + bj * 128 + n * 16) = w; }
                        ss += v[0] * v[0] + v[1] * v[1] + v[2] * v[2] + v[3] * v[3];
                    }
                if (sumsq) { ss += __shfl_xor(ss, 16); ss += __shfl_xor(ss, 32); if (fq == 0) unsafeAtomicAdd(sumsq + row, ss); }
                __builtin_amdgcn_sched_barrier(0);
            }
    }
};
struct EpiSwiglu {
    static constexpr bool PERM = true;
    bf16_t* H; const float* sumsq;
    __device__ __forceinline__ void operator()(AccRef acc, const Unit& u, int wr, int wc, int fr, int fq) const {
#pragma unroll
        for (int ai = 0; ai < 2; ++ai)
#pragma unroll
            for (int m = 0; m < 4; ++m) {
                const int row = u.pm * 256 + ai * 128 + wr * 64 + m * 16 + fr;
                const float rs = rsqrtf(sumsq[row] * (1.f / DM) + EPS);
                float h[8];
#pragma unroll
                for (int n = 0; n < 2; ++n)
#pragma unroll
                    for (int j = 0; j < 4; ++j) {
                        const float g = acc[ai][0][m][n][j] * rs, up = acc[ai][1][m][n][j] * rs;
                        h[n * 4 + j] = g * __builtin_amdgcn_rcpf(1.f + __builtin_amdgcn_exp2f(-1.4426950408889634f * g)) * up;
                    }
                u32x4 w = {cvt_pk_bf16(h[0], h[1]), cvt_pk_bf16(h[2], h[3]), cvt_pk_bf16(h[4], h[5]), cvt_pk_bf16(h[6], h[7])};
                *(u32x4*)(H + ((unsigned)row * DFF + u.pn * 128 + wc * 32 + fq * 8)) = w;
                __builtin_amdgcn_sched_barrier(0);
            }
    }
};
struct EpiSoftmax {
    static constexpr bool PERM = true;
    bf16_t* P; LAS float* ex;
    __device__ __forceinline__ void operator()(AccRef acc, const Unit& u, int wr, int wc, int fr, int fq) const {
        constexpr float SC = 0.04419417382415922f * 1.4426950408889634f;
        LAS float* ex2 = ex + 1024;
#pragma unroll
        for (int ai = 0; ai < 2; ++ai)
#pragma unroll
            for (int m = 0; m < 4; ++m) {
                float mx = -3.0e38f;
#pragma unroll
                for (int bj = 0; bj < 2; ++bj)
#pragma unroll
                    for (int n = 0; n < 2; ++n)
#pragma unroll
                        for (int j = 0; j < 4; ++j) mx = fmaxf(mx, acc[ai][bj][m][n][j]);
                mx = fmaxf(mx, __shfl_xor(mx, 16)); mx = fmaxf(mx, __shfl_xor(mx, 32));
                const int rl = ai * 128 + wr * 64 + m * 16 + fr;
                if (fq == 0) ex[rl * 4 + wc] = mx;
                __builtin_amdgcn_sched_barrier(0);
            }
        asm volatile("s_waitcnt lgkmcnt(0)" ::: "memory"); __builtin_amdgcn_s_barrier(); asm volatile("" ::: "memory");
#pragma unroll
        for (int ai = 0; ai < 2; ++ai)
#pragma unroll
            for (int m = 0; m < 4; ++m) {
                const int rl = ai * 128 + wr * 64 + m * 16 + fr;
                const f32x4 mv = *(const LAS f32x4*)(ex + rl * 4);
                const float mx = fmaxf(fmaxf(mv[0], mv[1]), fmaxf(mv[2], mv[3])) * SC;
                float sm = 0.f;
#pragma unroll
                for (int bj = 0; bj < 2; ++bj)
#pragma unroll
                    for (int n = 0; n < 2; ++n)
#pragma unroll
                        for (int j = 0; j < 4; ++j) { const float e = __builtin_amdgcn_exp2f(acc[ai][bj][m][n][j] * SC - mx); acc[ai][bj][m][n][j] = e; sm += e; }
                sm += __shfl_xor(sm, 16); sm += __shfl_xor(sm, 32);
                if (fq == 0) ex2[rl * 4 + wc] = sm;
                __builtin_amdgcn_sched_barrier(0);
            }
        asm volatile("s_waitcnt lgkmcnt(0)" ::: "memory"); __builtin_amdgcn_s_barrier(); asm volatile("" ::: "memory");
#pragma unroll
        for (int ai = 0; ai < 2; ++ai)
#pragma unroll
            for (int m = 0; m < 4; ++m) {
                const int rl = ai * 128 + wr * 64 + m * 16 + fr;
                const f32x4 sv = *(const LAS f32x4*)(ex2 + rl * 4);
                const float inv = 1.f / ((sv[0] + sv[1]) + (sv[2] + sv[3]));
                bf16_t* rowp = P + ((unsigned)(u.pm * 256 + rl) * 1024 + u.pn * 256 + wc * 32 + fq * 8);
#pragma unroll
                for (int bj = 0; bj < 2; ++bj) {
                    const f32x4 v0 = acc[ai][bj][m][0] * inv, v1 = acc[ai][bj][m][1] * inv;
                    u32x4 w = {cvt_pk_bf16(v0[0], v0[1]), cvt_pk_bf16(v0[2], v0[3]), cvt_pk_bf16(v1[0], v1[1]), cvt_pk_bf16(v1[2], v1[3])};
                    *(u32x4*)(rowp + bj * 128) = w;
                }
                __builtin_amdgcn_sched_barrier(0);
            }
    }
};
struct ScoreSched {
    const char* QC; const char* KM; int G, c;
    __device__ __forceinline__ bool next(int i, Unit& u) const {
        const long L = (long)i * G + c; if (L >= 640) return false;
        const int mt = (int)L >> 2, h = (int)L & 3, gb = mt < 128 ? (mt >> 5) : 4 + ((mt - 128) >> 4);
        u.pm = mt; u.pn = h; u.a = QC + ((size_t)mt * 256 * DM + h * 512) * 2; u.b = KM + ((size_t)gb * 256 * DM + h * 512) * 2; return true;
    }
};
struct PVSched {
    const char* PC; const char* VT; int G, c;
    __device__ __forceinline__ bool next(int i, Unit& u) const {
        const long L = (long)i * G + c; if (L >= 1280) return false;
        const int mt = (int)L >> 3, hn = (int)L & 7, gb = mt < 128 ? (mt >> 5) : 4 + ((mt - 128) >> 4);
        u.pm = mt; u.pn = hn; u.a = PC + ((size_t)mt * 256 * 1024 + (hn >> 1) * 256) * 2; u.b = VT + ((size_t)gb * DM + hn * 256) * 256 * 2; return true;
    }
};

constexpr int AT_LD = NPROJ, SHM_V = 64 * 128 * 2, SHM_K = 64 * 64 * 2;
constexpr float AT_SCALE = 0.125f, AT_THR = 8.f;
#define KSWZ64(row, colB) ((row) * 128 + ((colB) ^ ((((row) >> 1) & 7) << 4)))
#define SBAR() __builtin_amdgcn_sched_barrier(0)
__device__ __forceinline__ void at_partialSM(f32x16& p0, f32x16& p1, float& m_reg, float& mn, float& alpha) {
    constexpr float C = AT_SCALE * 1.4426950408889634f;
    float pmax = p0[0];
#pragma unroll
    for (int r = 1; r < 16; ++r) pmax = fmaxf(pmax, p0[r]);
#pragma unroll
    for (int r = 0; r < 16; ++r) pmax = fmaxf(pmax, p1[r]);
    { auto rr = __builtin_amdgcn_permlane32_swap(__float_as_uint(pmax), __float_as_uint(pmax), false, false);
      pmax = fmaxf(__uint_as_float(rr[0]), __uint_as_float(rr[1])); }
    if (__builtin_expect(__all(pmax - m_reg <= AT_THR / AT_SCALE), 1)) { mn = m_reg; alpha = 1.f; }
    else { mn = fmaxf(m_reg, pmax); alpha = __builtin_amdgcn_exp2f((m_reg - mn) * C); m_reg = mn; }
    const float mnC = -mn * C;
#pragma unroll
    for (int r = 0; r < 16; ++r) p0[r] = fmaf(p0[r], C, mnC);
#pragma unroll
    for (int r = 0; r < 16; ++r) p1[r] = fmaf(p1[r], C, mnC);
#pragma unroll
    for (int r = 0; r < 16; ++r) p0[r] = __builtin_amdgcn_exp2f(p0[r]);
}
__device__ __forceinline__ void at_finishSM(f32x16& p0, f32x16& p1, float alpha, float& l_reg, bf16x8& pa0, bf16x8& pa1, bf16x8& pa2, bf16x8& pa3) {
#pragma unroll
    for (int r = 0; r < 16; ++r) p1[r] = __builtin_amdgcn_exp2f(p1[r]);
    float ps = 0;
#pragma unroll
    for (int r = 0; r < 16; ++r) ps += p0[r];
#pragma unroll
    for (int r = 0; r < 16; ++r) ps += p1[r];
    { auto rr = __builtin_amdgcn_permlane32_swap(__float_as_uint(ps), __float_as_uint(ps), false, false);
      ps = __uint_as_float(rr[0]) + __uint_as_float(rr[1]); }
    l_reg = l_reg * alpha + ps;
#define PK4(P, BASE, OUT) do { unsigned a0 = cvt_pk_bf16(P[BASE + 0], P[BASE + 1]), a1 = cvt_pk_bf16(P[BASE + 2], P[BASE + 3]);   \
    unsigned b0 = cvt_pk_bf16(P[BASE + 4], P[BASE + 5]), b1 = cvt_pk_bf16(P[BASE + 6], P[BASE + 7]);                              \
    auto r0 = __builtin_amdgcn_permlane32_swap(a0, b0, false, false); auto r1 = __builtin_amdgcn_permlane32_swap(a1, b1, false, false); \
    u32x4 w = {r0[0], r1[0], r0[1], r1[1]}; OUT = *reinterpret_cast<bf16x8*>(&w); } while (0)
    PK4(p0, 0, pa0); PK4(p0, 8, pa1); PK4(p1, 0, pa2); PK4(p1, 8, pa3);
#undef PK4
}
__device__ __forceinline__ void at_qkt(f32x16& p0, f32x16& p1, const char* Ks, const bf16x8* qr, int r32, int hi) {
    p0 = f32x16{}; p1 = f32x16{};
#pragma unroll
    for (int d0 = 0; d0 < 4; ++d0) { const int cb = (d0 * 16 + hi * 8) * 2;
        bf16x8 b0 = *reinterpret_cast<const bf16x8*>(Ks + KSWZ64(r32, cb));
        bf16x8 b1 = *reinterpret_cast<const bf16x8*>(Ks + KSWZ64(32 + r32, cb));
        p0 = __builtin_amdgcn_mfma_f32_32x32x16_bf16(b0, qr[d0], p0, 0, 0, 0);
        p1 = __builtin_amdgcn_mfma_f32_32x32x16_bf16(b1, qr[d0], p1, 0, 0, 0); }
}
__device__ __forceinline__ int v_st(int k, int c) { const int kk = (k & ~0xC) | ((k & 4) << 1) | ((k & 8) >> 1); return ((kk >> 3) * 4 + (c >> 5)) * 512 + ((kk & 7) * 32 + (c & 31)) * 2; }
__device__ __forceinline__ int v_rd_base(int lane) { return ((lane & 3) << 3) | (((lane >> 2) & 3) << 6) | (((lane >> 4) & 1) << 5) | (((lane >> 5) & 1) << 8); }
constexpr int v_rd_off(int d0, int ks, int half) { return d0 * 512 + ks * 4096 + half * 2048; }
template <int OFF> __device__ __forceinline__ s16x4 tr_read(int vb) {
    s16x4 r; asm volatile("ds_read_b64_tr_b16 %0, %1 offset:%2" : "=&v"(r) : "v"(vb), "i"(OFF) : "memory"); return r;
}
template <int D0> __device__ __forceinline__ void pv_one(f32x16& od, int vb, bf16x8 pa0, bf16x8 pa1, bf16x8 pa2, bf16x8 pa3) {
    const s16x4 l0 = tr_read<v_rd_off(D0, 0, 0)>(vb), h0 = tr_read<v_rd_off(D0, 0, 1)>(vb), l1 = tr_read<v_rd_off(D0, 1, 0)>(vb), h1 = tr_read<v_rd_off(D0, 1, 1)>(vb);
    const s16x4 l2 = tr_read<v_rd_off(D0, 2, 0)>(vb), h2 = tr_read<v_rd_off(D0, 2, 1)>(vb), l3 = tr_read<v_rd_off(D0, 3, 0)>(vb), h3 = tr_read<v_rd_off(D0, 3, 1)>(vb);
    asm volatile("s_waitcnt lgkmcnt(0)" ::: "memory"); SBAR();
#define PK(L, H) (bf16x8){L[0], L[1], L[2], L[3], H[0], H[1], H[2], H[3]}
    od = __builtin_amdgcn_mfma_f32_32x32x16_bf16(pa0, PK(l0, h0), od, 0, 0, 0);
    od = __builtin_amdgcn_mfma_f32_32x32x16_bf16(pa1, PK(l1, h1), od, 0, 0, 0);
    od = __builtin_amdgcn_mfma_f32_32x32x16_bf16(pa2, PK(l2, h2), od, 0, 0, 0);
    od = __builtin_amdgcn_mfma_f32_32x32x16_bf16(pa3, PK(l3, h3), od, 0, 0, 0);
#undef PK
}
__device__ __forceinline__ void pv_d0(f32x16* o, int vb, bf16x8 pa0, bf16x8 pa1, bf16x8 pa2, bf16x8 pa3) {
    pv_one<0>(o[0], vb, pa0, pa1, pa2, pa3); pv_one<1>(o[1], vb, pa0, pa1, pa2, pa3); pv_one<2>(o[2], vb, pa0, pa1, pa2, pa3); pv_one<3>(o[3], vb, pa0, pa1, pa2, pa3);
}
template <int COMP>
__device__ __forceinline__ void attn_item(const bf16_t* __restrict__ Qb, const bf16_t* __restrict__ Kh, const bf16_t* __restrict__ Vh, const int seq, char* lds,
                                          const float lam, float* __restrict__ stash, bf16_t* __restrict__ outp, const float* __restrict__ gsub) {
    const int tid = opaque_tid(), wid = tid >> 6, lane = tid & 63, r32 = lane & 31, hi = lane >> 5;
    char* V_lds = lds; char* K_lds = lds + 2 * SHM_V;
    float* ws = (float*)(lds + 2 * SHM_V + 2 * SHM_K) + wid * 64; float* li_l = ws; float* al_l = ws + 32;
    float m_reg = -1e30f, l_reg = 0; f32x16 o[4] = {}; bf16x8 qr[4];
    const bf16_t* Qw = Qb + (long)(wid * 32 + r32) * AT_LD + hi * 8;
#pragma unroll
    for (int d0 = 0; d0 < 4; ++d0) qr[d0] = *reinterpret_cast<const bf16x8*>(Qw + d0 * 16);
    const int sr = tid >> 4, sc = (tid & 15) * 8, vst0 = v_st(sr, sc), vst1 = v_st(32 + sr, sc);
    const int kr = tid >> 3, kc = (tid & 7) * 8, kst = KSWZ64(kr, kc * 2);
    const int vb0 = (int)(uintptr_t)V_lds + v_rd_base(lane);
    bf16x8 sv0[2], sv1[2], sk[2];
#define SLOAD(i, k0) do { sv0[i] = *reinterpret_cast<const bf16x8*>(&Vh[(long)((k0) + sr) * AT_LD + sc]); sv1[i] = *reinterpret_cast<const bf16x8*>(&Vh[(long)((k0) + 32 + sr) * AT_LD + sc]); \
    sk[i] = *reinterpret_cast<const bf16x8*>(&Kh[(long)((k0) + kr) * AT_LD + kc]); } while (0)
#define SWRITE(b, i) do { *(bf16x8*)(V_lds + (b) * SHM_V + vst0) = sv0[i]; *(bf16x8*)(V_lds + (b) * SHM_V + vst1) = sv1[i]; *(bf16x8*)(K_lds + (b) * SHM_K + kst) = sk[i]; } while (0)
#define SWAIT() asm volatile("s_waitcnt vmcnt(3)" ::: "memory")
#define RESC(a) do { if (__any((a) < 1.f)) { if (hi == 0) al_l[r32] = (a); asm volatile("s_waitcnt lgkmcnt(0)" ::: "memory"); \
    _Pragma("unroll") for (int d = 0; d < 4; ++d) _Pragma("unroll") for (int r = 0; r < 16; ++r) o[d][r] *= al_l[crow(r, hi)]; } } while (0)
    f32x16 pA0, pA1, pB0, pB1; float mnA, mnB, alA, alB; bf16x8 pa0, pa1, pa2, pa3; const int NT = seq / 64;
    constexpr int SE = 0, SO = 1;
    __syncthreads();
    SLOAD(SE, 0); asm volatile("s_waitcnt vmcnt(0)" ::: "memory"); SWRITE(0, SE); __syncthreads();
    at_qkt(pA0, pA1, K_lds, qr, r32, hi); at_partialSM(pA0, pA1, m_reg, mnA, alA);
    SLOAD(SO, 64); if (2 < NT) SLOAD(SE, 128);
    SWAIT(); SWRITE(1, SO); __syncthreads();
    for (int j = 1; j + 1 < NT; j += 2) {
        SBAR(); at_qkt(pB0, pB1, K_lds + SHM_K, qr, r32, hi);
        at_finishSM(pA0, pA1, alA, l_reg, pa0, pa1, pa2, pa3); SBAR();
        SLOAD(SO, (j + 2) * 64); SBAR();
        pv_d0(o, vb0, pa0, pa1, pa2, pa3); at_partialSM(pB0, pB1, m_reg, mnB, alB);
        __syncthreads(); SWAIT(); SWRITE(0, SE);
        RESC(alB); __syncthreads();
        SBAR(); at_qkt(pA0, pA1, K_lds, qr, r32, hi);
        at_finishSM(pB0, pB1, alB, l_reg, pa0, pa1, pa2, pa3); SBAR();
        if (j + 3 < NT) SLOAD(SE, (j + 3) * 64); SBAR();
        pv_d0(o, vb0 + SHM_V, pa0, pa1, pa2, pa3); at_partialSM(pA0, pA1, m_reg, mnA, alA);
        __syncthreads(); SWAIT(); SWRITE(1, SO);
        RESC(alA); __syncthreads();
    }
    SBAR(); at_qkt(pB0, pB1, K_lds + SHM_K, qr, r32, hi);
    at_finishSM(pA0, pA1, alA, l_reg, pa0, pa1, pa2, pa3); SBAR();
    pv_d0(o, vb0, pa0, pa1, pa2, pa3); at_partialSM(pB0, pB1, m_reg, mnB, alB);
    __syncthreads(); RESC(alB);
    at_finishSM(pB0, pB1, alB, l_reg, pa0, pa1, pa2, pa3); SBAR();
    pv_d0(o, vb0 + SHM_V, pa0, pa1, pa2, pa3);
    if (hi == 0) li_l[r32] = l_reg; asm volatile("s_waitcnt lgkmcnt(0)" ::: "memory");
    float* Sw = stash + wid * 4096 + lane;
    if (COMP == 0) {
#pragma unroll
        for (int r = 0; r < 16; ++r) { const float rl = __builtin_amdgcn_rcpf(li_l[crow(r, hi)]);
#pragma unroll
            for (int d0 = 0; d0 < 4; ++d0) Sw[(r * 4 + d0) * 64] = o[d0][r] * rl; }
    } else {
        bf16_t* Ow = outp + (unsigned)(wid * 32 + 4 * hi) * DM + r32;
        float g4[4];
#pragma unroll
        for (int d0 = 0; d0 < 4; ++d0) g4[d0] = gsub[d0 * 32 + r32] * 0.8f;
#pragma unroll
        for (int r = 0; r < 16; ++r) { const float rl = __builtin_amdgcn_rcpf(li_l[crow(r, hi)]) * lam;
            float v[4]; float ss = 0.f;
#pragma unroll
            for (int d0 = 0; d0 < 4; ++d0) { v[d0] = Sw[(r * 4 + d0) * 64] - o[d0][r] * rl; ss += v[d0] * v[d0]; }
#pragma unroll
            for (int sh = 1; sh < 32; sh <<= 1) ss += __shfl_xor(ss, sh);
            const float rs = rsqrtf(ss * (1.f / 128.f) + 1e-5f);
#pragma unroll
            for (int d0 = 0; d0 < 4; ++d0) Ow[(unsigned)(((r & 3) + 8 * (r >> 2)) * DM + d0 * 32)] = f2bf(v[d0] * rs * g4[d0]);
            __builtin_amdgcn_sched_barrier(0); }
    }
#undef SLOAD
#undef SWRITE
#undef SWAIT
#undef RESC
}

__device__ __forceinline__ void attn_phase(const Params& p, char* lds) {
    const int lane = opaque_tid() & 63;
    const float s1 = wave_sum(p.lq1[lane] * p.lk1[lane]), s2 = wave_sum(p.lq2[lane] * p.lk2[lane]);
    const float lam = __expf(s1) - __expf(s2) + 0.2f;
    const bf16_t* PROJ = (const bf16_t*)(p.ws + WS_A);
    bf16_t* MIX = (bf16_t*)(p.ws + WS_C);
    for (int it = blockIdx.x; it < 1280; it += gridDim.x) {
        int gb, h, qb, seq;
        if (it < 1024) { const int rr = it >> 8, c = it & 255, bh = rr * 8 + (c & 7); gb = bh >> 3; h = bh & 7; qb = c >> 3; seq = 8192; }
        else { const int c = it - 1024, bh = (c & 7) * 2 + (c >> 7); gb = 4 + (bh >> 3); h = bh & 7; qb = (c >> 3) & 15; seq = 4096; }
        const int t0 = tok0_of(gb);
        const size_t row0 = (size_t)t0 + (size_t)qb * 256;
        float* stash = p.out + (size_t)it * 32768;
        bf16_t* outp = MIX + row0 * DM + 1024 + h * 128;
        const bf16_t* Kb = PROJ + (size_t)t0 * NPROJ + 3072 + h * 128; const bf16_t* Vb = PROJ + (size_t)t0 * NPROJ + 4096 + h * 128; const bf16_t* Qb = PROJ + row0 * NPROJ + 2048 + h * 128;
        attn_item<0>(Qb, Kb, Vb, seq, lds, lam, stash, outp, p.g_subln);
        attn_item<1>(Qb + 64, Kb + 64, Vb, seq, lds, lam, stash, outp, p.g_subln);
    }
}

__device__ __forceinline__ bf16x8 gatherB(const LAS bf16_t* Ds, int pitch, int kbase, int n) {
    bf16x8 b;
#pragma unroll
    for (int j = 0; j < 8; ++j) b[j] = (short)Ds[(kbase + j) * pitch + n];
    return b;
}
__device__ __forceinline__ void fftA_phase(const Params& p, LAS unsigned char* lds) {
    const int tid = opaque_tid(), wid = tid >> 6, lane = tid & 63, r32 = lane & 31, hi = lane >> 5;
    constexpr int PM = 136, PD = 136;
    LAS bf16_t* Ms = (LAS bf16_t*)lds; LAS bf16_t* Ds = (LAS bf16_t*)(lds + 128 * PM * 2);
    const bf16_t* PROJ = (const bf16_t*)(p.ws + WS_A); bf16_t* Y = (bf16_t*)(p.ws + WS_B); const bf16_t* FM = (const bf16_t*)(p.ws + WS_FMA);
    __syncthreads();
#pragma unroll
    for (int i = 0; i < 4; ++i) { const int q = tid + 512 * i, row = q >> 4, c8 = (q & 15) * 8; *(LAS u32x4*)(Ms + row * PM + c8) = *(const u32x4*)(FM + row * 128 + c8); }
    u32x4 st[4];
    auto decode = [&](int u, int& t0, int& s2, int& c0, int& N2, int& S) {
        if (u < 4096) { t0 = (u >> 10) * 8192; const int rem = u & 1023; s2 = rem >> 3; c0 = (rem & 7) * 128; N2 = 128; S = 8192; }
        else { const int v = u - 4096; t0 = 32768 + (v >> 9) * 4096; const int rem = v & 511; s2 = rem >> 3; c0 = (rem & 7) * 128; N2 = 64; S = 4096; } };
    auto loadu = [&](int u) { int t0, s2, c0, N2, S; decode(u, t0, s2, c0, N2, S);
#pragma unroll
        for (int i = 0; i < 4; ++i) { const int q = tid + 512 * i, row = q >> 4, c8 = (q & 15) * 8, pp = row >> 6, s1 = row & 63;
            st[i] = *(const u32x4*)(PROJ + (size_t)(t0 + s1 * N2 + s2) * NPROJ + pp * 1024 + c0 + c8); } };
    int u = blockIdx.x;
    if (u < 5120) loadu(u);
    for (; u < 5120; u += gridDim.x) {
        __syncthreads();
#pragma unroll
        for (int i = 0; i < 4; ++i) { const int q = tid + 512 * i, row = q >> 4, c8 = (q & 15) * 8; *(LAS u32x4*)(Ds + row * PD + c8) = st[i]; }
        __syncthreads();
        if (u + (int)gridDim.x < 5120) loadu(u + gridDim.x);
        int t0, s2, c0, N2, S; decode(u, t0, s2, c0, N2, S);
        const int nb = wid & 3, mp = wid >> 2;
        f32x16 a0 = {}, a1 = {};
#pragma unroll
        for (int ks = 0; ks < 8; ++ks) { const int kb = ks * 16 + hi * 8;
            const bf16x8 b = gatherB(Ds, PD, kb, nb * 32 + r32);
            const bf16x8 m0 = *(const LAS bf16x8*)(Ms + (mp * 32 + r32) * PM + kb), m1 = *(const LAS bf16x8*)(Ms + (64 + mp * 32 + r32) * PM + kb);
            a0 = __builtin_amdgcn_mfma_f32_32x32x16_bf16(m0, b, a0, 0, 0, 0); a1 = __builtin_amdgcn_mfma_f32_32x32x16_bf16(m1, b, a1, 0, 0, 0); }
        const float invS = 1.f / (float)S;
#pragma unroll
        for (int r = 0; r < 16; ++r) { const int k1 = mp * 32 + crow(r, hi); const int j = (s2 * k1) & (S - 1); const float fr = (float)j * invS;
            const float cs = __builtin_amdgcn_cosf(fr), sn = __builtin_amdgcn_sinf(fr);
            const float yr = a0[r], yi = a1[r], orr = yr * cs + yi * sn, oi = yi * cs - yr * sn;
            bf16_t* d = Y + (size_t)(t0 + k1 * N2 + s2) * DM + c0 + nb * 32 + r32;
            d[0] = f2bf(orr); d[1024] = f2bf(oi); }
    }
}
template <int N2>
__device__ __forceinline__ void fftC_phase(const Params& p, LAS unsigned char* lds) {
    const int tid = opaque_tid(), wid = tid >> 6, lane = tid & 63, r32 = lane & 31, hi = lane >> 5;
    constexpr int KD = 2 * N2, PM = KD + 8, PD = 72, S = 64 * N2, NPC = KD * 8 / 512  , NU = (N2 == 128 ? 4096 : 2048);
    LAS bf16_t* Ms = (LAS bf16_t*)lds; LAS bf16_t* Ds = (LAS bf16_t*)(lds + 128 * 264 * 2);
    const bf16_t* Y = (const bf16_t*)(p.ws + WS_B); bf16_t* MIX = (bf16_t*)(p.ws + WS_C); const bf16_t* FM = (const bf16_t*)(p.ws + (N2 == 128 ? WS_FMC128 : WS_FMC64));
    const float scale = N2 == 128 ? 9.765625e-4f   : 1.3810679320049757e-3f  ;
    __syncthreads();
    for (int q = tid; q < N2 * KD / 8; q += 512) { const int row = q / (KD / 8), c8 = (q % (KD / 8)) * 8; *(LAS u32x4*)(Ms + row * PM + c8) = *(const u32x4*)(FM + row * KD + c8); }
    u32x4 st[NPC];
    auto decode = [&](int u, int& t0, int& k1, int& c0) { const int gbl = u >> 10; t0 = (N2 == 128 ? gbl * 8192 : 32768 + gbl * 4096); k1 = (u >> 4) & 63; c0 = (u & 15) * 64; };
    auto loadu = [&](int u) { int t0, k1, c0; decode(u, t0, k1, c0);
#pragma unroll
        for (int i = 0; i < NPC; ++i) { const int q = tid + 512 * i, row = q >> 3, c8 = (q & 7) * 8, pp = row / N2, s2 = row % N2;
            st[i] = *(const u32x4*)(Y + (size_t)(t0 + k1 * N2 + s2) * DM + pp * 1024 + c0 + c8); } };
    int u = blockIdx.x;
    if (u < NU) loadu(u);
    for (; u < NU; u += gridDim.x) {
        __syncthreads();
#pragma unroll
        for (int i = 0; i < NPC; ++i) { const int q = tid + 512 * i, row = q >> 3, c8 = (q & 7) * 8; *(LAS u32x4*)(Ds + row * PD + c8) = st[i]; }
        __syncthreads();
        if (u + (int)gridDim.x < NU) loadu(u + gridDim.x);
        int t0, k1, c0; decode(u, t0, k1, c0);
        constexpr int NMB = N2 / 32;
        const int mb = wid % NMB, nb = wid / NMB;
        if (nb < 2) {
            f32x16 a0 = {};
#pragma unroll
            for (int ks = 0; ks < KD / 16; ++ks) { const int kb = ks * 16 + hi * 8;
                const bf16x8 b = gatherB(Ds, PD, kb, nb * 32 + r32);
                const bf16x8 m0 = *(const LAS bf16x8*)(Ms + (mb * 32 + r32) * PM + kb);
                a0 = __builtin_amdgcn_mfma_f32_32x32x16_bf16(m0, b, a0, 0, 0, 0); }
#pragma unroll
            for (int r = 0; r < 16; ++r) { const int k2 = mb * 32 + crow(r, hi);
                MIX[(size_t)(t0 + k1 + 64 * k2) * DM + c0 + nb * 32 + r32] = f2bf(a0[r] * scale); }
        }
    }
}

__device__ __forceinline__ void p0_tr_item(const float* __restrict__ W, int ldw, int k0, int n0, bf16_t* __restrict__ WT, int ldt, int kd0, int drow0, int dstride,
                                           const float* __restrict__ ksc, LAS float* scr, int lane) {
#pragma unroll 8
    for (int i = 0; i < 32; ++i) { const int kk = 2 * i + (lane >> 5); float v = W[(size_t)(k0 + kk) * ldw + n0 + (lane & 31)]; if (ksc) v *= ksc[k0 + kk]; scr[kk * 33 + (lane & 31)] = v; }
    asm volatile("s_waitcnt lgkmcnt(0)" ::: "memory");
    const int c = lane & 7;
#pragma unroll
    for (int j = 0; j < 4; ++j) { const int n = (lane >> 3) + 8 * j; const LAS float* s = scr + (8 * c) * 33 + n;
        u32x4 o = {cvt_pk_bf16(s[0 * 33], s[1 * 33]), cvt_pk_bf16(s[2 * 33], s[3 * 33]), cvt_pk_bf16(s[4 * 33], s[5 * 33]), cvt_pk_bf16(s[6 * 33], s[7 * 33])};
        *(u32x4*)(WT + (size_t)(drow0 + dstride * n) * ldt + kd0 + 8 * c) = o; }
    asm volatile("s_waitcnt lgkmcnt(0)" ::: "memory");
}
__device__ __forceinline__ void norm_row_bf16(const float* __restrict__ xrow, const float* __restrict__ g, bf16_t* __restrict__ orow, int lane) {
    const f32x4* xr = (const f32x4*)xrow + lane; const f32x4* gr = (const f32x4*)g + lane;
    f32x4 v[8]; float s = 0.f;
#pragma unroll
    for (int j = 0; j < 8; ++j) { v[j] = xr[64 * j]; s += (v[j][0] * v[j][0] + v[j][1] * v[j][1]) + (v[j][2] * v[j][2] + v[j][3] * v[j][3]); }
    const float rs = rsqrtf(wave_sum(s) * (1.f / DM) + EPS);
#pragma unroll
    for (int j = 0; j < 8; ++j) { const f32x4 gg = gr[64 * j]; u32x2 w = {cvt_pk_bf16(v[j][0] * rs * gg[0], v[j][1] * rs * gg[1]), cvt_pk_bf16(v[j][2] * rs * gg[2], v[j][3] * rs * gg[3])};
        *((u32x2*)orow + lane + 64 * j) = w; }
}
__device__ __forceinline__ void p0_prologue(const Params& p, LAS unsigned char* lds) {
    const int tid = opaque_tid(), wid = tid >> 6, lane = tid & 63, G = gridDim.x;
    bf16_t* WIN = (bf16_t*)(p.ws + WS_WIN); bf16_t* WOUT = (bf16_t*)(p.ws + WS_WOUT);
    for (int it = blockIdx.x; it < 256; it += G) {
        const int g = it & 7, k0 = (it >> 3) * 64;
        LAS float* As = (LAS float*)lds; LAS float* tab = As + 64 * 129;
        __syncthreads();
        for (int q = tid; q < 64 * 128; q += 512) { const int kk = q >> 7, c = q & 127; As[kk * 129 + c] = p.w_in[(size_t)(k0 + kk) * 4096 + g * 128 + c]; }
        if (tid < 128) tab[tid] = __builtin_amdgcn_cosf((float)tid * (1.f / 128.f));
        __syncthreads();
        const int k = tid & 63, cgp = tid >> 6;
        float re[16], im[16];
#pragma unroll
        for (int j = 0; j < 16; ++j) { re[j] = 0.f; im[j] = 0.f; }
        for (int c = 0; c < 128; ++c) { const float a = As[k * 129 + c];
#pragma unroll
            for (int j = 0; j < 16; ++j) { const int idx = (c * (cgp * 16 + j)) & 127; re[j] += a * tab[idx]; im[j] -= a * tab[(idx - 32) & 127]; } }
#pragma unroll
        for (int j = 0; j < 16; ++j) { const int cp = cgp * 16 + j; WIN[(size_t)(g * 128 + cp) * DM + k0 + k] = f2bf(re[j]); WIN[(size_t)(1024 + g * 128 + cp) * DM + k0 + k] = f2bf(im[j]); }
    }
    for (int it = blockIdx.x; it < 256; it += G) {
        const int g = it & 7, n0 = (it >> 3) * 64;
        LAS float* Fs = (LAS float*)lds; LAS float* Bs = Fs + 128 * 129;
        __syncthreads();
        for (int q = tid; q < 128 * 128; q += 512) { const int cp = q >> 7, d = q & 127; Fs[cp * 129 + d] = p.w_f[(size_t)g * 16384 + q]; }
        for (int q = tid; q < 128 * 64; q += 512) { const int d = q >> 6, n = q & 63; Bs[d * 65 + n] = p.w_out[(size_t)(g * 128 + d) * DM + n0 + n]; }
        __syncthreads();
        const int n = tid & 63, cgp = tid >> 6;
        float acc[16];
#pragma unroll
        for (int j = 0; j < 16; ++j) acc[j] = 0.f;
        for (int d = 0; d < 128; ++d) { const float b = Bs[d * 65 + n];
#pragma unroll
            for (int j = 0; j < 16; ++j) acc[j] += Fs[(cgp * 16 + j) * 129 + d] * b; }
        u32x4 w0 = {cvt_pk_bf16(acc[0], acc[1]), cvt_pk_bf16(acc[2], acc[3]), cvt_pk_bf16(acc[4], acc[5]), cvt_pk_bf16(acc[6], acc[7])};
        u32x4 w1 = {cvt_pk_bf16(acc[8], acc[9]), cvt_pk_bf16(acc[10], acc[11]), cvt_pk_bf16(acc[12], acc[13]), cvt_pk_bf16(acc[14], acc[15])};
        bf16_t* d = WOUT + (size_t)(n0 + n) * DM + g * 128 + cgp * 16;
        *(u32x4*)d = w0; *(u32x4*)(d + 8) = w1;
    }
    __syncthreads();
    {
        LAS float* scr = (LAS float*)lds + wid * (64 * 33);
        const int gw = blockIdx.x * 8 + wid, GW = G * 8;
        for (int it = gw; it < 29184; it += GW) {
            int r = it;
            if (r < 3072) { const int kb = r / 96, nb = r % 96, n = nb * 32; int drow0, dstr;
                if (n < 2048) { const int d = n & 63; drow0 = 2048 + (n & ~63) + (d >> 5); dstr = 2; } else { drow0 = 2048 + n; dstr = 1; }
                p0_tr_item(p.w_in, 4096, kb * 64, 1024 + n, WIN, DM, kb * 64, drow0, dstr, nullptr, scr, lane); continue; } r -= 3072;
            if (r < 1024) { const int kb = r >> 6, nb = r & 63; p0_tr_item(p.w_out, DM, 1024 + kb * 64, nb * 32, WOUT, DM, 1024 + kb * 64, nb * 32, 1, nullptr, scr, lane); continue; } r -= 1024;
            if (r < 8192) { const int w = r >> 11, q = r & 2047, kb = q >> 6, nb = q & 63;
                const float* W = w == 0 ? p.w_cq : w == 1 ? p.w_ck : w == 2 ? p.w_cv : p.w_co;
                bf16_t* WT = (bf16_t*)(p.ws + (w == 0 ? WS_WCQ : w == 1 ? WS_WCK : w == 2 ? WS_WCV : WS_WCO));
                p0_tr_item(W, DM, kb * 64, nb * 32, WT, DM, kb * 64, nb * 32, 1, w == 0 ? p.g_cross : nullptr, scr, lane); continue; } r -= 8192;
            if (r < 11264) { const int up = r >= 5632, q = up ? r - 5632 : r, kb = q / 176, nb = q % 176, n0 = nb * 32;
                p0_tr_item(up ? p.w_up : p.w_gate, DFF, kb * 64, n0, (bf16_t*)(p.ws + WS_WGU), DM, kb * 64, 256 * (n0 >> 7) + (n0 & 127) + (up ? 128 : 0), 1, p.g_ffn, scr, lane); continue; } r -= 11264;
            { const int kb = r >> 6, nb = r & 63; p0_tr_item(p.w_down, DM, kb * 64, nb * 32, (bf16_t*)(p.ws + WS_WD), DFF, kb * 64, nb * 32, 1, nullptr, scr, lane); }
        }
        bf16_t* HA = (bf16_t*)(p.ws + WS_B); bf16_t* MEMN = (bf16_t*)(p.ws + WS_MEMN);
        for (int row = gw; row < T_ALL + NMEMROWS; row += GW) {
            if (row < T_ALL) norm_row_bf16(row < T_P ? p.x_p + (size_t)row * DM : p.x_s + (size_t)(row - T_P) * DM, p.g_mix, HA + (size_t)row * DM, lane);
            else { const int mr = row - T_ALL; norm_row_bf16(mr < 1024 ? p.mem_p + (size_t)mr * DM : p.mem_s + (size_t)(mr - 1024) * DM, p.g_mem, MEMN + (size_t)mr * DM, lane); }
        }
    }
    const int gt = blockIdx.x * 512 + tid, GT = G * 512;
    float* sumsq = (float*)(p.ws + WS_SUMSQ);
    for (int i = gt; i < 3 * T_ALL; i += GT) sumsq[i] = 0.f;
    float* rope = (float*)(p.ws + WS_ROPE);
    for (int i = gt; i < 8192 * 32; i += GT) { const int pos = i >> 5, fi = i & 31;
        const double inv = exp2(-(double)fi * 0.41524101186092029), rev = (double)pos * inv * 0.15915494309189535; const float fr = (float)(rev - floor(rev));
        rope[2 * i] = __builtin_amdgcn_cosf(fr); rope[2 * i + 1] = __builtin_amdgcn_sinf(fr); }
    bf16_t* FMA_ = (bf16_t*)(p.ws + WS_FMA); bf16_t* FC128 = (bf16_t*)(p.ws + WS_FMC128); bf16_t* FC64 = (bf16_t*)(p.ws + WS_FMC64);
    for (int i = gt; i < 128 * 128; i += GT) { const int r = i >> 7, c = i & 127, pp = r >> 6, k1 = r & 63, pc = c >> 6, s1 = c & 63; const float fr = (float)((k1 * s1) & 63) * (1.f / 64.f);
        const float cs = __builtin_amdgcn_cosf(fr), sn = __builtin_amdgcn_sinf(fr); FMA_[i] = f2bf(pp == pc ? cs : (pp == 0 ? sn : -sn)); }
    for (int i = gt; i < 128 * 256; i += GT) { const int k2 = i >> 8, c = i & 255, pc = c >> 7, s2 = c & 127; const float fr = (float)((k2 * s2) & 127) * (1.f / 128.f);
        FC128[i] = f2bf(pc == 0 ? __builtin_amdgcn_cosf(fr) : __builtin_amdgcn_sinf(fr)); }
    for (int i = gt; i < 64 * 128; i += GT) { const int k2 = i >> 7, c = i & 127, pc = c >> 6, s2 = c & 63; const float fr = (float)((k2 * s2) & 63) * (1.f / 64.f);
        FC64[i] = f2bf(pc == 0 ? __builtin_amdgcn_cosf(fr) : __builtin_amdgcn_sinf(fr)); }
}
__device__ __forceinline__ void final_norm_phase(const Params& p) {
    const int tid = opaque_tid(), wid = tid >> 6, lane = tid & 63;
    for (int row = blockIdx.x * 8 + wid; row < T_ALL; row += gridDim.x * 8) {
        f32x4* xr = (f32x4*)(p.out + (size_t)row * DM) + lane; const f32x4* gr = (const f32x4*)p.g_final + lane;
        f32x4 v[8]; float s = 0.f;
#pragma unroll
        for (int j = 0; j < 8; ++j) { v[j] = xr[64 * j]; s += (v[j][0] * v[j][0] + v[j][1] * v[j][1]) + (v[j][2] * v[j][2] + v[j][3] * v[j][3]); }
        const float rs = rsqrtf(wave_sum(s) * (1.f / DM) + EPS);
#pragma unroll
        for (int j = 0; j < 8; ++j) xr[64 * j] = v[j] * rs * gr[64 * j];
    }
}

__global__ void __launch_bounds__(512, 2) mega(Params p) {
    extern __shared__ __attribute__((aligned(16))) char shm[];
    LAS unsigned char* lds = (LAS unsigned char*)shm;
    cg::grid_group grid = cg::this_grid();
    unsigned char* ws = p.ws;
    float* sumsq = (float*)(ws + WS_SUMSQ);
#define PHASE(n, ...) if (p.ph_lo <= (n) && (n) < p.ph_hi) { if ((n) > p.ph_lo) grid.sync(); if (PHMASK & (1 << (n))) { __VA_ARGS__ } }
    PHASE(0, p0_prologue(p, lds);)
    PHASE(1,
        { pg8::PlainSched S; S.init(ws + WS_B, ws + WS_WIN, T_ALL, NPROJ, DM, DM); EpiProj E{(bf16_t*)(ws + WS_A), (const float*)(ws + WS_ROPE)}; pg8::gemm_phase(lds, DM, DM, DM, S, E); }
        { pg8::PlainSched S; S.init(ws + WS_MEMN, ws + WS_WCK, NMEMROWS, DM, DM, DM); EpiStore E{(bf16_t*)(ws + WS_KMEM), DM, 0, 256, nullptr}; pg8::gemm_phase(lds, DM, DM, DM, S, E); }
        { pg8::PlainSched S; S.init(ws + WS_WCV, ws + WS_MEMN, DM, NMEMROWS, DM, DM); EpiStore E{(bf16_t*)(ws + WS_VMEMT), 256, (long)DM * 256, 0, nullptr}; pg8::gemm_phase(lds, DM, DM, DM, S, E); })
    PHASE(2, fftA_phase(p, lds); if (PHMASK & (1 << 12)) attn_phase(p, shm);)
    PHASE(3, fftC_phase<128>(p, lds); fftC_phase<64>(p, lds);)
    PHASE(4, { pg8::PlainSched S; S.init(ws + WS_C, ws + WS_WOUT, T_ALL, DM, DM, DM); EpiRes E{p.x_p, p.x_s, p.out, (bf16_t*)(ws + WS_B), sumsq}; pg8::gemm_phase(lds, DM, DM, DM, S, E); })
    PHASE(5, { pg8::PlainSched S; S.init(ws + WS_B, ws + WS_WCQ, T_ALL, DM, DM, DM); EpiStore E{(bf16_t*)(ws + WS_A), DM, 0, 256, sumsq}; pg8::gemm_phase(lds, DM, DM, DM, S, E); })
    PHASE(6, { ScoreSched S{(const char*)(ws + WS_A), (const char*)(ws + WS_KMEM), (int)gridDim.x, (int)blockIdx.x};
               EpiSoftmax E{(bf16_t*)(ws + WS_A + (size_t)T_ALL * DM * 2), (LAS float*)(lds + 131072)}; pg8::gemm_phase(lds, 512, DM, DM, S, E); })
    PHASE(7, { PVSched S{(const char*)(ws + WS_A + (size_t)T_ALL * DM * 2), (const char*)(ws + WS_VMEMT), (int)gridDim.x, (int)blockIdx.x};
               EpiStore E{(bf16_t*)(ws + WS_C), DM, 0, 256, nullptr}; pg8::gemm_phase(lds, 256, 1024, 256, S, E); })
    PHASE(8, { pg8::PlainSched S; S.init(ws + WS_C, ws + WS_WCO, T_ALL, DM, DM, DM); EpiRes E{p.out, p.out + (size_t)T_P * DM, p.out, (bf16_t*)(ws + WS_B), sumsq + T_ALL}; pg8::gemm_phase(lds, DM, DM, DM, S, E); })
    PHASE(9, { pg8::PlainSched S; S.init(ws + WS_B, ws + WS_WGU, T_ALL, 2 * DFF, DM, DM); EpiSwiglu E{(bf16_t*)(ws + WS_A), sumsq + T_ALL}; pg8::gemm_phase(lds, DM, DM, DM, S, E); })
    PHASE(10, { pg8::PlainSched S; S.init(ws + WS_A, ws + WS_WD, T_ALL, DM, DFF, DFF); EpiRes E{p.out, p.out + (size_t)T_P * DM, p.out, nullptr, nullptr}; pg8::gemm_phase(lds, DFF, DFF, DFF, S, E); })
    PHASE(11, final_norm_phase(p);)
}

extern "C" void kernel_launch(void* const* d_in, const int* in_sizes, int n_in, void* d_out, int out_size, void* d_ws, size_t ws_size, hipStream_t stream) {
    static int grid_blocks = 0;
    if (!grid_blocks) {
        if (n_in != 24 || ws_size < WS_END) { fprintf(stderr, "kernel_launch: unexpected n_in %d / ws %zu (need %zu)\n", n_in, ws_size, (size_t)WS_END); return; }
        int dev = 0, cus = 0, per_cu = 0;
        hipGetDevice(&dev);
        hipDeviceGetAttribute(&cus, hipDeviceAttributeMultiprocessorCount, dev);
        if (hipFuncSetAttribute((const void*)mega, hipFuncAttributeMaxDynamicSharedMemorySize, LDS_BYTES) != hipSuccess) { fprintf(stderr, "kernel_launch: hipFuncSetAttribute failed\n"); return; }
        hipOccupancyMaxActiveBlocksPerMultiprocessor(&per_cu, mega, 512, LDS_BYTES);
        if (per_cu < 1) { fprintf(stderr, "kernel_launch: occupancy query returned %d\n", per_cu); per_cu = 1; }
        grid_blocks = cus;
    }
    Params p{};
    const float** pp = (const float**)&p;
    for (int i = 0; i < 24; ++i) pp[i] = (const float*)d_in[i];
    p.out = (float*)d_out; p.ws = (unsigned char*)d_ws;
#if ONE_LAUNCH
    p.ph_lo = 0; p.ph_hi = NPHASE;
    void* args[] = {&p};
    hipError_t e = hipLaunchCooperativeKernel((const void*)mega, dim3(grid_blocks), dim3(512), args, LDS_BYTES, stream);
    if (e != hipSuccess) fprintf(stderr, "cooperative launch failed: %s (grid %d)\n", hipGetErrorString(e), grid_blocks);
#else
    for (int ph = 0; ph < NPHASE; ++ph) { p.ph_lo = ph; p.ph_hi = ph + 1; hipLaunchKernelGGL(mega, dim3(grid_blocks), dim3(512), LDS_BYTES, stream, p); }
#endif
}
```

```cpp
#include <hip/hip_runtime.h>
#include <hip/hip_cooperative_groups.h>
#include <cstdio>
#include <cstdint>
namespace cg = cooperative_groups;

#ifndef PROBE_CONST
#define PROBE_CONST 0.f
#endif
#ifndef PHMASK
#define PHMASK 0x1FFF
#endif
#ifndef ONE_LAUNCH
#define ONE_LAUNCH 1
#endif

#define LAS __attribute__((address_space(3)))
typedef unsigned short bf16_t;
typedef short bf16x8 __attribute__((ext_vector_type(8)));
typedef short s16x4 __attribute__((ext_vector_type(4)));
typedef float f32x4 __attribute__((ext_vector_type(4)));
typedef float f32x16 __attribute__((ext_vector_type(16)));
typedef unsigned u32x4 __attribute__((ext_vector_type(4)));
typedef unsigned u32x2 __attribute__((ext_vector_type(2)));

constexpr int DM = 2048, T_P = 32768, T_ALL = 40960, NPROJ = 5120, DFF = 5632, NMEMROWS = 1536;
constexpr float EPS = 1e-6f;
constexpr int NPHASE = 12;
constexpr int LDS_BYTES = 147456;

constexpr size_t al256(size_t x) { return (x + 255) / 256 * 256; }
constexpr size_t WS_SUMSQ = 0;
constexpr size_t WS_ROPE = al256(WS_SUMSQ + 3ull * T_ALL * 4);
constexpr size_t WS_FMA = al256(WS_ROPE + 8192ull * 32 * 8);
constexpr size_t WS_FMC128 = al256(WS_FMA + 128 * 128 * 2);
constexpr size_t WS_FMC64 = al256(WS_FMC128 + 128 * 256 * 2);
constexpr size_t WS_MEMN = al256(WS_FMC64 + 64 * 128 * 2);
constexpr size_t WS_KMEM = al256(WS_MEMN + (size_t)NMEMROWS * DM * 2);
constexpr size_t WS_VMEMT = al256(WS_KMEM + (size_t)NMEMROWS * DM * 2);
constexpr size_t WS_WIN = al256(WS_VMEMT + (size_t)NMEMROWS * DM * 2);
constexpr size_t WS_WOUT = al256(WS_WIN + (size_t)NPROJ * DM * 2);
constexpr size_t WS_WCQ = al256(WS_WOUT + (size_t)DM * DM * 2);
constexpr size_t WS_WCK = al256(WS_WCQ + (size_t)DM * DM * 2);
constexpr size_t WS_WCV = al256(WS_WCK + (size_t)DM * DM * 2);
constexpr size_t WS_WCO = al256(WS_WCV + (size_t)DM * DM * 2);
constexpr size_t WS_WGU = al256(WS_WCO + (size_t)DM * DM * 2);
constexpr size_t WS_WD = al256(WS_WGU + 2ull * DFF * DM * 2);
constexpr size_t WS_A = al256(WS_WD + (size_t)DM * DFF * 2);
constexpr size_t WS_C = al256(WS_A + (size_t)T_ALL * NPROJ * 2);
constexpr size_t WS_B = al256(WS_C + (size_t)T_ALL * DM * 2);
constexpr size_t WS_END = WS_B + (size_t)T_ALL * DM * 2;
constexpr size_t WS_FCT = al256(WS_END + 1024);
constexpr size_t WS_TS = WS_END;
static_assert(WS_FCT + 65536 <= (1ull << 30), "workspace");
static_assert((size_t)T_ALL * DFF * 2 <= (WS_B - WS_A), "HFF fits A+C");

struct Params {
    const float *x_p, *x_s, *mem_p, *mem_s, *g_mix, *w_in, *w_f, *lq1, *lk1, *lq2, *lk2, *g_subln, *w_out, *g_cross, *g_mem, *w_cq, *w_ck, *w_cv, *w_co,
        *g_ffn, *w_gate, *w_up, *w_down, *g_final;
    float* out; unsigned char* ws; int ph_lo, ph_hi;
};

__device__ __forceinline__ unsigned cvt_pk_bf16(float lo, float hi) { unsigned r; asm volatile("v_cvt_pk_bf16_f32 %0, %1, %2" : "=v"(r) : "v"(lo), "v"(hi)); return r; }
__device__ __forceinline__ bf16_t f2bf(float f) { return (bf16_t)(cvt_pk_bf16(f, 0.f) & 0xffffu); }
__device__ __forceinline__ bf16_t f2bf_rne(float f) { unsigned u = __float_as_uint(f); u += 0x7fffu + ((u >> 16) & 1u); return (bf16_t)(u >> 16); }
__device__ __forceinline__ float wave_sum(float v) {
#pragma unroll
    for (int o = 1; o < 64; o <<= 1) v += __shfl_xor(v, o);
    return v;
}
__device__ __forceinline__ int opaque_tid() { int t = threadIdx.x; asm volatile("" : "+v"(t)); return t; }
__device__ __forceinline__ int tok0_of(int gb) { return gb < 4 ? gb * 8192 : 32768 + (gb - 4) * 4096; }
__device__ __forceinline__ int crow(int r, int hi) { return (r & 3) + 8 * (r >> 2) + 4 * hi; }

namespace pg8 {
constexpr int BM = 256, BK = 64, HALF = 128, HTB = HALF * BK * 2, STAGE_BYTES = 8 * HTB, NXCD = 8, WGM = 8;
__device__ __forceinline__ int lds_byte(int r, int c) { const int st = (r >> 4) * 2 + (c >> 5), rr = r & 15, cc = c & 31, ob = rr * 64 + cc * 2; return st * 1024 + (ob ^ (((ob >> 9) & 1) << 5)); }
__device__ __forceinline__ void stage_rc(int b, int& R, int& C) { const int st = b / 1024, sb = b % 1024, swz = sb ^ (((sb >> 9) & 1) << 5); R = (st >> 1) * 16 + swz / 64; C = (st & 1) * 32 + (swz % 64) / 2; }
__device__ __forceinline__ int perm32(int rho) { const int n = rho >> 4, i = rho & 15; return 8 * (i >> 2) + 4 * n + (i & 3); }
struct Unit { const char* a; const char* b; int pm, pn, kind; };

struct PlainSched {
    const char* A; const char* B; int nM, nN, nwg, G, c; long tsA, tsB;
    __device__ void init(const void* A_, const void* B_, int M, int N, int lda, int ldb) {
        A = (const char*)A_; B = (const char*)B_; nM = M / BM; nN = N / BM; nwg = nM * nN; G = gridDim.x; c = blockIdx.x; tsA = (long)BM * lda * 2; tsB = (long)BM * ldb * 2; }
    __device__ __forceinline__ bool next(int i, Unit& u) const { const long L = (long)i * G + c; if (L >= nwg) return false; map((int)L, u); return true; }
    __device__ __forceinline__ void map(int L, Unit& u) const {
        int wgid = L; { const int q = nwg / NXCD, r = nwg % NXCD, xcd = wgid % NXCD, off = wgid / NXCD; wgid = (xcd < r ? xcd * (q + 1) : r * (q + 1) + (xcd - r) * q) + off; }
        const int nig = WGM * nN, gid = wgid / nig, fm = gid * WGM, gsz = (nM - fm) < WGM ? (nM - fm) : WGM;
        u.pm = fm + ((wgid % nig) % gsz); u.pn = (wgid % nig) / gsz;
        u.a = A + (long)u.pm * tsA; u.b = B + (long)u.pn * tsB; u.kind = 0;
    }
};

template <bool ALIGN_EPI = true, bool SP2 = true, class Epi, class Sched>
__device__ __forceinline__ void gemm_phase(LAS unsigned char* lds, const int K, const int lda, const int ldb, const Sched& S, const Epi& E) {
    const int tid = opaque_tid(), wid = __builtin_amdgcn_readfirstlane(tid >> 6), lane = tid & 63, wr = wid >> 2, wc = wid & 3, fr = lane & 15, fq = lane >> 4;
    const int nt = K / BK;
    unsigned voffA[2], voffB[2];
#pragma unroll
    for (int i = 0; i < 2; ++i) { int R, C; stage_rc(tid * 16 + i * 8192, R, C); const int Rb = Epi::PERM ? ((R & ~31) + perm32(R & 31)) : R;
        voffA[i] = (unsigned)(R * lda + C) * 2u; voffB[i] = (unsigned)(Rb * ldb + C) * 2u; }
    const size_t kstep = (size_t)(BK * 2);
    const size_t hstepA = (size_t)HALF * lda * 2, hstepB = (size_t)HALF * ldb * 2;
    const unsigned ldsw = (unsigned)wid * 1024u;
    const int aoff = lds_byte(wr * 64 + fr, fq * 8), boff = lds_byte(wc * 32 + fr, fq * 8);
#define PG8_SA(b, h) (((b) * 2 + (h)) * HTB)
#define PG8_SB(b, h) ((4 + (b) * 2 + (h)) * HTB)
#define PG8_STAGE(bufoff, gbase, voff) do { _Pragma("unroll") for (int _i = 0; _i < 2; ++_i) \
        __builtin_amdgcn_global_load_lds((const unsigned*)((const char*)(gbase) + (voff)[_i]), (LAS unsigned*)(lds + (bufoff) + ldsw + _i * 8192), 16, 0, 0); } while (0)
#define PG8_LDA(dst, b, h) do { _Pragma("unroll") for (int m = 0; m < 4; ++m) _Pragma("unroll") for (int k = 0; k < 2; ++k) dst[m][k] = *(const LAS bf16x8*)(lds + PG8_SA(b, h) + aoff + m * 2048 + k * 1024); } while (0)
#define PG8_LDB(dst, b, h) do { _Pragma("unroll") for (int n = 0; n < 2; ++n) _Pragma("unroll") for (int k = 0; k < 2; ++k) dst[n][k] = *(const LAS bf16x8*)(lds + PG8_SB(b, h) + boff + n * 2048 + k * 1024); } while (0)
#define PG8_MMA(ai, bj, At, Bt) do { __builtin_amdgcn_s_setprio(1); _Pragma("unroll") for (int m = 0; m < 4; ++m) _Pragma("unroll") for (int n = 0; n < 2; ++n) _Pragma("unroll") for (int k = 0; k < 2; ++k) \
        acc[ai][bj][m][n] = __builtin_amdgcn_mfma_f32_16x16x32_bf16(Bt[n][k], At[m][k], acc[ai][bj][m][n], 0, 0, 0); __builtin_amdgcn_s_setprio(0); } while (0)
#define PG8_WAIT_V(n) asm volatile("s_waitcnt vmcnt(" #n ")" ::: "memory")
#define PG8_WAIT_L(n) asm volatile("s_waitcnt lgkmcnt(" #n ")" ::: "memory")
#define PG8_BAR __builtin_amdgcn_s_barrier()
#define PG8_SCHED __builtin_amdgcn_sched_barrier(0)
    Unit cur, nxt; int ui = 0;
    if (!S.next(0, cur)) return;
    f32x4 acc[2][2][4][2];
#pragma unroll
    for (int a = 0; a < 2; ++a)
#pragma unroll
        for (int b = 0; b < 2; ++b)
#pragma unroll
            for (int m = 0; m < 4; ++m)
#pragma unroll
                for (int n = 0; n < 2; ++n) acc[a][b][m][n] = (f32x4){0.f, 0.f, 0.f, 0.f};
    bf16x8 At[4][2], B0[2][2], B1[2][2];
    const char* cA = cur.a; const char* cB = cur.b;
    if constexpr (SP2) {
        PG8_STAGE(PG8_SB(0, 0), cB, voffB); PG8_STAGE(PG8_SB(0, 1), cB + hstepB, voffB); PG8_STAGE(PG8_SA(0, 0), cA, voffA); PG8_STAGE(PG8_SA(0, 1), cA + hstepA, voffA);
        if (wr == 1) PG8_BAR;
        PG8_WAIT_V(2); PG8_BAR;
        PG8_STAGE(PG8_SB(1, 0), cB + kstep, voffB); PG8_STAGE(PG8_SA(1, 0), cA + kstep, voffA); PG8_STAGE(PG8_SB(1, 1), cB + hstepB + kstep, voffB);
        PG8_WAIT_V(6); PG8_BAR;
    } else {
        PG8_STAGE(PG8_SB(0, 0), cB, voffB); PG8_STAGE(PG8_SA(0, 0), cA, voffA); PG8_STAGE(PG8_SB(0, 1), cB + hstepB, voffB); PG8_STAGE(PG8_SA(0, 1), cA + hstepA, voffA);
        if (wr == 1) PG8_BAR;
        PG8_WAIT_V(4); PG8_BAR;
        PG8_STAGE(PG8_SB(1, 0), cB + kstep, voffB); PG8_STAGE(PG8_SA(1, 0), cA + kstep, voffA); PG8_STAGE(PG8_SB(1, 1), cB + hstepB + kstep, voffB);
        PG8_WAIT_V(6); PG8_BAR;
    }
    for (;;) {
        const bool has_next = S.next(ui + 1, nxt);
        const char* nA = has_next ? nxt.a : cA; const char* nB = has_next ? nxt.b : cB;
#pragma unroll 1
        for (int t = 0; t < nt; t += 2) {
            const bool last = (t == nt - 2);
            const char* a1 = cA + (size_t)(t + 1) * kstep;
            const char* a2 = last ? nA : cA + (size_t)(t + 2) * kstep; const char* b2 = last ? nB : cB + (size_t)(t + 2) * kstep;
            const char* a3 = a2 + kstep; const char* b3 = b2 + kstep;
            if constexpr (SP2) {
            PG8_LDB(B0, 0, 0); PG8_LDB(B1, 0, 1); PG8_SCHED; PG8_LDA(At, 0, 0); PG8_STAGE(PG8_SA(1, 1), a1 + hstepA, voffA);
            PG8_WAIT_V(8); PG8_WAIT_L(0); PG8_BAR; PG8_MMA(0, 0, At, B0); PG8_MMA(0, 1, At, B1); PG8_BAR; PG8_SCHED;
            PG8_LDA(At, 0, 1); PG8_STAGE(PG8_SB(0, 0), b2, voffB); PG8_STAGE(PG8_SB(0, 1), b2 + hstepB, voffB); PG8_STAGE(PG8_SA(0, 0), a2, voffA);
            PG8_WAIT_V(8); PG8_WAIT_L(0); PG8_BAR; PG8_MMA(1, 0, At, B0); PG8_MMA(1, 1, At, B1); PG8_BAR; PG8_SCHED;
            PG8_LDB(B0, 1, 0); PG8_LDB(B1, 1, 1); PG8_SCHED; PG8_LDA(At, 1, 0); PG8_STAGE(PG8_SA(0, 1), a2 + hstepA, voffA);
            PG8_WAIT_V(8); PG8_WAIT_L(0); PG8_BAR; PG8_MMA(0, 0, At, B0); PG8_MMA(0, 1, At, B1); PG8_BAR; PG8_SCHED;
            PG8_LDA(At, 1, 1); PG8_STAGE(PG8_SB(1, 0), b3, voffB); PG8_STAGE(PG8_SB(1, 1), b3 + hstepB, voffB); PG8_STAGE(PG8_SA(1, 0), a3, voffA);
            PG8_WAIT_V(8); PG8_WAIT_L(0); PG8_BAR; PG8_MMA(1, 0, At, B0); PG8_MMA(1, 1, At, B1); PG8_BAR; PG8_SCHED;
            } else {
            PG8_LDB(B0, 0, 0); PG8_SCHED; PG8_LDA(At, 0, 0); PG8_STAGE(PG8_SA(1, 1), a1 + hstepA, voffA);
            PG8_WAIT_L(8); PG8_BAR; PG8_WAIT_L(0); PG8_MMA(0, 0, At, B0); PG8_BAR; PG8_SCHED;
            PG8_LDB(B1, 0, 1); PG8_STAGE(PG8_SB(0, 0), b2, voffB);
            PG8_BAR; PG8_WAIT_L(0); PG8_MMA(0, 1, At, B1); PG8_BAR;
            PG8_LDA(At, 0, 1); PG8_STAGE(PG8_SA(0, 0), a2, voffA);
            PG8_BAR; PG8_WAIT_L(0); PG8_MMA(1, 0, At, B0); PG8_BAR; PG8_SCHED;
            PG8_STAGE(PG8_SB(0, 1), b2 + hstepB, voffB);
            PG8_WAIT_V(6); PG8_BAR; PG8_MMA(1, 1, At, B1); PG8_BAR;
            PG8_LDB(B0, 1, 0); PG8_SCHED; PG8_LDA(At, 1, 0); PG8_STAGE(PG8_SA(0, 1), a2 + hstepA, voffA);
            PG8_WAIT_L(8); PG8_BAR; PG8_WAIT_L(0); PG8_MMA(0, 0, At, B0); PG8_BAR; PG8_SCHED;
            PG8_LDB(B1, 1, 1); PG8_STAGE(PG8_SB(1, 0), b3, voffB);
            PG8_BAR; PG8_WAIT_L(0); PG8_MMA(0, 1, At, B1); PG8_BAR;
            PG8_LDA(At, 1, 1); PG8_STAGE(PG8_SA(1, 0), a3, voffA);
            PG8_BAR; PG8_WAIT_L(0); PG8_MMA(1, 0, At, B0); PG8_BAR; PG8_SCHED;
            PG8_STAGE(PG8_SB(1, 1), b3 + hstepB, voffB);
            PG8_WAIT_V(6); PG8_BAR; PG8_MMA(1, 1, At, B1); PG8_BAR;
                    }
        }
        if constexpr (ALIGN_EPI) { if (wr == 0) PG8_BAR; }
        E(acc, cur, wr, wc, fr, fq);
        if (!has_next) break;
#pragma unroll
        for (int a = 0; a < 2; ++a)
#pragma unroll
            for (int b = 0; b < 2; ++b)
#pragma unroll
                for (int m = 0; m < 4; ++m)
#pragma unroll
                    for (int n = 0; n < 2; ++n) acc[a][b][m][n] = (f32x4){0.f, 0.f, 0.f, 0.f};
        cur = nxt; cA = nA; cB = nB; ++ui;
        if constexpr (ALIGN_EPI) { if (wr == 1) PG8_BAR; }
    }
    PG8_WAIT_V(0);
    if constexpr (!ALIGN_EPI) { if (wr == 0) PG8_BAR; }
    PG8_BAR;
#undef PG8_SA
#undef PG8_SB
#undef PG8_STAGE
#undef PG8_LDA
#undef PG8_LDB
#undef PG8_MMA
#undef PG8_WAIT_V
#undef PG8_WAIT_L
#undef PG8_BAR
#undef PG8_SCHED
}
}
using pg8::Unit;
typedef f32x4 (&AccRef)[2][2][4][2];

struct EpiProj {
    static constexpr bool PERM = true;
    bf16_t* O; const float* rope; bf16_t* KH; bf16_t* VH;
    __device__ __forceinline__ void operator()(AccRef acc, const Unit& u, int wr, int wc, int fr, int fq) const {
        const bool rp = (u.pn >= 4 && u.pn < 12);
        const int kind = u.pn < 8 ? 0 : (u.pn < 12 ? 1 : 2);
#pragma unroll
        for (int ai = 0; ai < 2; ++ai)
#pragma unroll
            for (int m = 0; m < 4; ++m) {
                const int row = u.pm * 256 + ai * 128 + wr * 64 + m * 16 + fr;
                const int pos = row < T_P ? (row & 8191) : (row & 4095);
                const int S = row < T_P ? 8192 : 4096;
                bf16_t* dst; unsigned ro, bjs;
                if (kind == 0) { dst = O; ro = (unsigned)row * NPROJ + u.pn * 256 + wc * 32 + fq * 8; bjs = 128; }
                else if (kind == 1) { dst = KH; ro = (unsigned)(row - pos) * 1024 + (unsigned)(((u.pn - 8) * 4 + (wc >> 1)) * S + pos) * 64 + (wc & 1) * 32 + fq * 8; bjs = 2 * S * 64; }
                else { dst = VH; ro = (unsigned)(row - pos) * 1024 + (unsigned)((u.pn - 12) * 2 * S + pos) * 128 + wc * 32 + fq * 8; bjs = S * 128; }
#pragma unroll
                for (int bj = 0; bj < 2; ++bj) {
                    f32x4 v0 = acc[ai][bj][m][0], v1 = acc[ai][bj][m][1];
                    if (rp) {
                        const unsigned i0 = ((wc * 32 + fq * 8) & 63) >> 1;
                        const unsigned rto = ((unsigned)pos * 32 + i0) * 2;
                        const f32x4 r0 = *(const f32x4*)(rope + rto), r1 = *(const f32x4*)(rope + rto + 4);
                        float a, b;
                        a = v0[0] * r0[0] - v0[1] * r0[1]; b = v0[1] * r0[0] + v0[0] * r0[1]; v0[0] = a; v0[1] = b;
                        a = v0[2] * r0[2] - v0[3] * r0[3]; b = v0[3] * r0[2] + v0[2] * r0[3]; v0[2] = a; v0[3] = b;
                        a = v1[0] * r1[0] - v1[1] * r1[1]; b = v1[1] * r1[0] + v1[0] * r1[1]; v1[0] = a; v1[1] = b;
                        a = v1[2] * r1[2] - v1[3] * r1[3]; b = v1[3] * r1[2] + v1[2] * r1[3]; v1[2] = a; v1[3] = b;
                    }
                    u32x4 w = {cvt_pk_bf16(v0[0], v0[1]), cvt_pk_bf16(v0[2], v0[3]), cvt_pk_bf16(v1[0], v1[1]), cvt_pk_bf16(v1[2], v1[3])};
                    *(u32x4*)(dst + ro + bj * bjs) = w;
                }
                __builtin_amdgcn_sched_barrier(0);
            }
    }
};
struct EpiStore {
    static constexpr bool PERM = true;
    bf16_t* O; int ldc; long pn_stride; int col_per_pn; const float* sumsq;
    __device__ __forceinline__ void operator()(AccRef acc, const Unit& u, int wr, int wc, int fr, int fq) const {
        bf16_t* base = O + (size_t)u.pn * pn_stride + u.pn * col_per_pn;
        float ssq[2][4];
#pragma unroll
        for (int ai = 0; ai < 2; ++ai)
#pragma unroll
            for (int m = 0; m < 4; ++m) ssq[ai][m] = sumsq ? sumsq[u.pm * 256 + ai * 128 + wr * 64 + m * 16 + fr] : 0.f;
#pragma unroll
        for (int ai = 0; ai < 2; ++ai)
#pragma unroll
            for (int m = 0; m < 4; ++m) {
                const int row = u.pm * 256 + ai * 128 + wr * 64 + m * 16 + fr;
                float rs = 1.f;
                if (sumsq) rs = rsqrtf(ssq[ai][m] * (1.f / DM) + EPS);
                const unsigned ro = (unsigned)row * (unsigned)ldc + wc * 32 + fq * 8;
#pragma unroll
                for (int bj = 0; bj < 2; ++bj) {
                    const f32x4 v0 = acc[ai][bj][m][0] * rs, v1 = acc[ai][bj][m][1] * rs;
                    u32x4 w = {cvt_pk_bf16(v0[0], v0[1]), cvt_pk_bf16(v0[2], v0[3]), cvt_pk_bf16(v1[0], v1[1]), cvt_pk_bf16(v1[2], v1[3])};
                    *(u32x4*)(base + ro + bj * 128) = w;
                }
                __builtin_amdgcn_sched_barrier(0);
            }
    }
};
template <bool XBF, bool OUTF32>
struct EpiRes {
    static constexpr bool PERM = true;
    const float* X0; const float* X1; const bf16_t* XBin; float* OUT; bf16_t* XBout; float* sumsq;
    struct Res { f32x4 f[2][2]; u32x4 b[2]; };
    __device__ __forceinline__ void load(Res& r, const float* xb_, unsigned o) const {
#pragma unroll
        for (int bj = 0; bj < 2; ++bj) {
            if (XBF) r.b[bj] = *(const u32x4*)(XBin + o + bj * 128);
            else { r.f[bj][0] = *(const f32x4*)(xb_ + o + bj * 128); r.f[bj][1] = *(const f32x4*)(xb_ + o + bj * 128 + 4); } }
    }
    __device__ __forceinline__ void operator()(AccRef acc, const Unit& u, int wr, int wc, int fr, int fq) const {
        const float* xb_ = (u.pm < T_P / 256) ? X0 : X1 - (size_t)T_P * DM;
        const unsigned o0 = (unsigned)(u.pm * 256 + wr * 64 + fr) * DM + u.pn * 256 + wc * 32 + fq * 8;
        Res ra, rb;
        load(ra, xb_, o0);
#pragma unroll
        for (int i = 0; i < 8; ++i) {
            const int ai = i >> 2, m = i & 3;
            const unsigned o = o0 + (unsigned)(ai * 128 + m * 16) * DM;
            Res& cur = (i & 1) ? rb : ra; Res& nxt = (i & 1) ? ra : rb;
            if (i + 1 < 8) load(nxt, xb_, o0 + (unsigned)(((i + 1) >> 2) * 128 + ((i + 1) & 3) * 16) * DM);
            const int row = u.pm * 256 + ai * 128 + wr * 64 + m * 16 + fr;
            float ss = 0.f;
#pragma unroll
            for (int bj = 0; bj < 2; ++bj) {
                f32x4 x0, x1;
                if (XBF) { const u32x4 r = cur.b[bj];
                    x0 = (f32x4){__uint_as_float(r[0] << 16), __uint_as_float(r[0] & 0xffff0000u), __uint_as_float(r[1] << 16), __uint_as_float(r[1] & 0xffff0000u)};
                    x1 = (f32x4){__uint_as_float(r[2] << 16), __uint_as_float(r[2] & 0xffff0000u), __uint_as_float(r[3] << 16), __uint_as_float(r[3] & 0xffff0000u)};
                } else { x0 = cur.f[bj][0]; x1 = cur.f[bj][1]; }
                const f32x4 v0 = x0 + acc[ai][bj][m][0], v1 = x1 + acc[ai][bj][m][1];
                if (OUTF32) { *(f32x4*)(OUT + o + bj * 128) = v0; *(f32x4*)(OUT + o + bj * 128 + 4) = v1; }
                else { u32x4 w = {cvt_pk_bf16(v0[0], v0[1]), cvt_pk_bf16(v0[2], v0[3]), cvt_pk_bf16(v1[0], v1[1]), cvt_pk_bf16(v1[2], v1[3])}; *(u32x4*)(XBout + o + bj * 128) = w; }
                ss += (v0[0] * v0[0] + v0[1] * v0[1]) + (v0[2] * v0[2] + v0[3] * v0[3]) + (v1[0] * v1[0] + v1[1] * v1[1]) + (v1[2] * v1[2] + v1[3] * v1[3]);
            }
            if (sumsq) { ss += __shfl_xor(ss, 16); ss += __shfl_xor(ss, 32); if (fq == 0) unsafeAtomicAdd(sumsq + row, ss); }
            __builtin_amdgcn_sched_barrier(0);
        }
    }
};
struct EpiSwiglu {
    static constexpr bool PERM = true;
    bf16_t* H; const float* sumsq;
    __device__ __forceinline__ void operator()(AccRef acc, const Unit& u, int wr, int wc, int fr, int fq) const {
        float ssq[2][4];
#pragma unroll
        for (int ai = 0; ai < 2; ++ai)
#pragma unroll
            for (int m = 0; m < 4; ++m) ssq[ai][m] = sumsq[u.pm * 256 + ai * 128 + wr * 64 + m * 16 + fr];
#pragma unroll
        for (int ai = 0; ai < 2; ++ai)
#pragma unroll
            for (int m = 0; m < 4; ++m) {
                const int row = u.pm * 256 + ai * 128 + wr * 64 + m * 16 + fr;
                const float rs = rsqrtf(ssq[ai][m] * (1.f / DM) + EPS);
                float h[8];
#pragma unroll
                for (int n = 0; n < 2; ++n)
#pragma unroll
                    for (int j = 0; j < 4; ++j) {
                        const float g = acc[ai][0][m][n][j] * rs, up = acc[ai][1][m][n][j] * rs;
                        h[n * 4 + j] = g * __builtin_amdgcn_rcpf(1.f + __builtin_amdgcn_exp2f(-1.4426950408889634f * g)) * up;
                    }
                u32x4 w = {cvt_pk_bf16(h[0], h[1]), cvt_pk_bf16(h[2], h[3]), cvt_pk_bf16(h[4], h[5]), cvt_pk_bf16(h[6], h[7])};
                *(u32x4*)(H + ((unsigned)row * DFF + u.pn * 128 + wc * 32 + fq * 8)) = w;
                __builtin_amdgcn_sched_barrier(0);
            }
    }
};
struct EpiSoftmax {
    static constexpr bool PERM = true;
    bf16_t* P; LAS float* ex; const float* sumsq;
    __device__ __forceinline__ void operator()(AccRef acc, const Unit& u, int wr, int wc, int fr, int fq) const {
        constexpr float SC = 0.04419417382415922f * 1.4426950408889634f;
        LAS float* ex2 = ex + 1024;
        float rsc[2][4];
#pragma unroll
        for (int ai = 0; ai < 2; ++ai)
#pragma unroll
            for (int m = 0; m < 4; ++m) rsc[ai][m] = rsqrtf(sumsq[u.pm * 256 + ai * 128 + wr * 64 + m * 16 + fr] * (1.f / DM) + EPS) * SC;
#pragma unroll
        for (int ai = 0; ai < 2; ++ai)
#pragma unroll
            for (int m = 0; m < 4; ++m) {
                float mx = -3.0e38f;
#pragma unroll
                for (int bj = 0; bj < 2; ++bj)
#pragma unroll
                    for (int n = 0; n < 2; ++n)
#pragma unroll
                        for (int j = 0; j < 4; ++j) mx = fmaxf(mx, acc[ai][bj][m][n][j]);
                mx = fmaxf(mx, __shfl_xor(mx, 16)); mx = fmaxf(mx, __shfl_xor(mx, 32));
                const int rl = ai * 128 + wr * 64 + m * 16 + fr;
                if (fq == 0) ex[rl * 4 + wc] = mx;
                __builtin_amdgcn_sched_barrier(0);
            }
        asm volatile("s_waitcnt lgkmcnt(0)" ::: "memory"); __builtin_amdgcn_s_barrier(); asm volatile("" ::: "memory");
#pragma unroll
        for (int ai = 0; ai < 2; ++ai)
#pragma unroll
            for (int m = 0; m < 4; ++m) {
                const int rl = ai * 128 + wr * 64 + m * 16 + fr;
                const f32x4 mv = *(const LAS f32x4*)(ex + rl * 4);
                const float sc_ = rsc[ai][m]; const float mx = fmaxf(fmaxf(mv[0], mv[1]), fmaxf(mv[2], mv[3])) * sc_;
                float sm = 0.f;
#pragma unroll
                for (int bj = 0; bj < 2; ++bj)
#pragma unroll
                    for (int n = 0; n < 2; ++n)
#pragma unroll
                        for (int j = 0; j < 4; ++j) { const float e = __builtin_amdgcn_exp2f(acc[ai][bj][m][n][j] * sc_ - mx); acc[ai][bj][m][n][j] = e; sm += e; }
                sm += __shfl_xor(sm, 16); sm += __shfl_xor(sm, 32);
                if (fq == 0) ex2[rl * 4 + wc] = sm;
                __builtin_amdgcn_sched_barrier(0);
            }
        asm volatile("s_waitcnt lgkmcnt(0)" ::: "memory"); __builtin_amdgcn_s_barrier(); asm volatile("" ::: "memory");
#pragma unroll
        for (int ai = 0; ai < 2; ++ai)
#pragma unroll
            for (int m = 0; m < 4; ++m) {
                const int rl = ai * 128 + wr * 64 + m * 16 + fr;
                const f32x4 sv = *(const LAS f32x4*)(ex2 + rl * 4);
                const float inv = 1.f / ((sv[0] + sv[1]) + (sv[2] + sv[3]));
                bf16_t* rowp = P + ((unsigned)(u.pm * 256 + rl) * 1024 + u.pn * 256 + wc * 32 + fq * 8);
#pragma unroll
                for (int bj = 0; bj < 2; ++bj) {
                    const f32x4 v0 = acc[ai][bj][m][0] * inv, v1 = acc[ai][bj][m][1] * inv;
                    u32x4 w = {cvt_pk_bf16(v0[0], v0[1]), cvt_pk_bf16(v0[2], v0[3]), cvt_pk_bf16(v1[0], v1[1]), cvt_pk_bf16(v1[2], v1[3])};
                    *(u32x4*)(rowp + bj * 128) = w;
                }
                __builtin_amdgcn_sched_barrier(0);
            }
    }
};
struct PrepSched {
    const char* KM; const char* WQ; int G, c;
    __device__ __forceinline__ bool next(int i, Unit& u) const {
        const long L = (long)i * G + c; if (L >= 192) return false;
        const int bh = (int)L >> 3, nt = (int)L & 7, gb = bh >> 2, h = bh & 3;
        u.kind = 0; u.pm = bh; u.pn = nt; u.a = KM + ((size_t)gb * 256 * DM + h * 512) * 2; u.b = WQ + ((size_t)nt * 256 * DM + h * 512) * 2; return true;
    }
};
struct ScoreSched {
    const char* XB; const char* WPT; int G, c;
    __device__ __forceinline__ bool next(int i, Unit& u) const {
        const long L = (long)i * G + c; if (L >= 640) return false;
        const int mt = (int)L >> 2, h = (int)L & 3, gb = mt < 128 ? (mt >> 5) : 4 + ((mt - 128) >> 4);
        u.kind = 0; u.pm = mt; u.pn = h; u.a = XB + (size_t)mt * 256 * DM * 2; u.b = WPT + (size_t)((gb * 4 + h) * 256) * DM * 2; return true;
    }
};
struct Prep2Sched {
    const char* WCO; const char* VM; int G, c;
    __device__ __forceinline__ bool next(int i, Unit& u) const {
        if (c < 0) return false;
        const long L = (long)i * G + c; if (L >= 192) return false;
        const int bh = (int)L >> 3, mtile = (int)L & 7, gb = bh >> 2, h = bh & 3;
        u.kind = 0; u.pm = gb * 8 + mtile; u.pn = h; u.a = WCO + ((size_t)mtile * 256 * DM + h * 512) * 2; u.b = VM + ((size_t)gb * 256 * DM + h * 512) * 2; return true;
    }
};
struct OutSched {
    pg8::PlainSched ps; const char* VWT;
    __device__ __forceinline__ bool next(int i, Unit& u) const {
        if (!ps.next(i, u)) return false;
        const int gb = u.pm < 128 ? (u.pm >> 5) : 4 + ((u.pm - 128) >> 4);
        u.b = VWT + ((size_t)(gb * DM + u.pn * 256) * 1024) * 2; return true;
    }
};

struct P1Sched {
    pg8::PlainSched ps; const char* MEMN; const char* WCK; const char* WCV;
    __device__ __forceinline__ bool next(int i, Unit& u) const {
        const long L = (long)i * ps.G + ps.c;
        if (L < 2560) { ps.map((int)L, u); return true; }
        if (L < 2608) { const int j = (int)L - 2560; u.pm = j >> 3; u.pn = j & 7; u.kind = 1; u.a = MEMN + (size_t)u.pm * 256 * DM * 2; u.b = WCK + (size_t)u.pn * 256 * DM * 2; return true; }
        if (L < 2656) { const int j = (int)L - 2608; u.pm = j >> 3; u.pn = j & 7; u.kind = 2; u.a = MEMN + (size_t)u.pm * 256 * DM * 2; u.b = WCV + (size_t)u.pn * 256 * DM * 2; return true; }
        return false;
    }
};
struct EpiP1 {
    static constexpr bool PERM = true;
    EpiProj ep; EpiStore ek; EpiStore ev;
    __device__ __forceinline__ void operator()(AccRef acc, const Unit& u, int wr, int wc, int fr, int fq) const {
        if (u.kind == 0) ep(acc, u, wr, wc, fr, fq); else if (u.kind == 1) ek(acc, u, wr, wc, fr, fq); else ev(acc, u, wr, wc, fr, fq);
    }
};

constexpr int AT_LD = NPROJ, AT_LDK = 64, AT_LDV = 128, SHM_V = 64 * 128 * 2, SHM_K = 64 * 64 * 2;
constexpr float AT_SCALE = 0.125f, AT_THR = 8.f;
#define KSWZ64(row, colB) ((row) * 128 + ((colB) ^ ((((row) >> 1) & 7) << 4)))
#define SBAR() __builtin_amdgcn_sched_barrier(0)
__device__ __forceinline__ void at_partialSM(f32x16& p0, f32x16& p1, float& m_reg, float& mn, float& alpha) {
    constexpr float C = AT_SCALE * 1.4426950408889634f;
    float pmax = p0[0];
#pragma unroll
    for (int r = 1; r < 16; ++r) pmax = fmaxf(pmax, p0[r]);
#pragma unroll
    for (int r = 0; r < 16; ++r) pmax = fmaxf(pmax, p1[r]);
    { auto rr = __builtin_amdgcn_permlane32_swap(__float_as_uint(pmax), __float_as_uint(pmax), false, false);
      pmax = fmaxf(__uint_as_float(rr[0]), __uint_as_float(rr[1])); }
    if (__builtin_expect(__all(pmax - m_reg <= AT_THR / AT_SCALE), 1)) { mn = m_reg; alpha = 1.f; }
    else { mn = fmaxf(m_reg, pmax); alpha = __builtin_amdgcn_exp2f((m_reg - mn) * C); m_reg = mn; }
    const float mnC = -mn * C;
#pragma unroll
    for (int r = 0; r < 16; ++r) p0[r] = fmaf(p0[r], C, mnC);
#pragma unroll
    for (int r = 0; r < 16; ++r) p1[r] = fmaf(p1[r], C, mnC);
#pragma unroll
    for (int r = 0; r < 16; ++r) p0[r] = __builtin_amdgcn_exp2f(p0[r]);
}
__device__ __forceinline__ void at_finishSM(f32x16& p0, f32x16& p1, float alpha, float& l_reg, bf16x8& pa0, bf16x8& pa1, bf16x8& pa2, bf16x8& pa3) {
#pragma unroll
    for (int r = 0; r < 16; ++r) p1[r] = __builtin_amdgcn_exp2f(p1[r]);
    float ps = 0;
#pragma unroll
    for (int r = 0; r < 16; ++r) ps += p0[r];
#pragma unroll
    for (int r = 0; r < 16; ++r) ps += p1[r];
    { auto rr = __builtin_amdgcn_permlane32_swap(__float_as_uint(ps), __float_as_uint(ps), false, false);
      ps = __uint_as_float(rr[0]) + __uint_as_float(rr[1]); }
    l_reg = l_reg * alpha + ps;
#define PK4(P, BASE, OUT) do { unsigned a0 = cvt_pk_bf16(P[BASE + 0], P[BASE + 1]), a1 = cvt_pk_bf16(P[BASE + 2], P[BASE + 3]);   \
    unsigned b0 = cvt_pk_bf16(P[BASE + 4], P[BASE + 5]), b1 = cvt_pk_bf16(P[BASE + 6], P[BASE + 7]);                              \
    auto r0 = __builtin_amdgcn_permlane32_swap(a0, b0, false, false); auto r1 = __builtin_amdgcn_permlane32_swap(a1, b1, false, false); \
    u32x4 w = {r0[0], r1[0], r0[1], r1[1]}; OUT = *reinterpret_cast<bf16x8*>(&w); } while (0)
    PK4(p0, 0, pa0); PK4(p0, 8, pa1); PK4(p1, 0, pa2); PK4(p1, 8, pa3);
#undef PK4
}
__device__ __forceinline__ void at_qkt(f32x16& p0, f32x16& p1, const char* Ks, const bf16x8* qr, int r32, int hi) {
    p0 = f32x16{}; p1 = f32x16{};
#pragma unroll
    for (int d0 = 0; d0 < 4; ++d0) { const int cb = (d0 * 16 + hi * 8) * 2;
        bf16x8 b0 = *reinterpret_cast<const bf16x8*>(Ks + KSWZ64(r32, cb));
        bf16x8 b1 = *reinterpret_cast<const bf16x8*>(Ks + KSWZ64(32 + r32, cb));
        p0 = __builtin_amdgcn_mfma_f32_32x32x16_bf16(b0, qr[d0], p0, 0, 0, 0);
        p1 = __builtin_amdgcn_mfma_f32_32x32x16_bf16(b1, qr[d0], p1, 0, 0, 0); }
}
__device__ __forceinline__ int v_st(int k, int c) { const int kk = (k & ~0xC) | ((k & 4) << 1) | ((k & 8) >> 1); return ((kk >> 3) * 4 + (c >> 5)) * 512 + ((kk & 7) * 32 + (c & 31)) * 2; }
__device__ __forceinline__ int v_rd_base(int lane) { return ((lane & 3) << 3) | (((lane >> 2) & 3) << 6) | (((lane >> 4) & 1) << 5) | (((lane >> 5) & 1) << 8); }
constexpr int v_rd_off(int d0, int ks, int half) { return d0 * 512 + ks * 4096 + half * 2048; }
template <int OFF> __device__ __forceinline__ s16x4 tr_read(int vb) {
    s16x4 r; asm volatile("ds_read_b64_tr_b16 %0, %1 offset:%2" : "=&v"(r) : "v"(vb), "i"(OFF) : "memory"); return r;
}
template <int D0> __device__ __forceinline__ void pv_one(f32x16& od, int vb, bf16x8 pa0, bf16x8 pa1, bf16x8 pa2, bf16x8 pa3) {
    const s16x4 l0 = tr_read<v_rd_off(D0, 0, 0)>(vb), h0 = tr_read<v_rd_off(D0, 0, 1)>(vb), l1 = tr_read<v_rd_off(D0, 1, 0)>(vb), h1 = tr_read<v_rd_off(D0, 1, 1)>(vb);
    const s16x4 l2 = tr_read<v_rd_off(D0, 2, 0)>(vb), h2 = tr_read<v_rd_off(D0, 2, 1)>(vb), l3 = tr_read<v_rd_off(D0, 3, 0)>(vb), h3 = tr_read<v_rd_off(D0, 3, 1)>(vb);
    asm volatile("s_waitcnt lgkmcnt(0)" ::: "memory"); SBAR();
#define PK(L, H) (bf16x8){L[0], L[1], L[2], L[3], H[0], H[1], H[2], H[3]}
    od = __builtin_amdgcn_mfma_f32_32x32x16_bf16(pa0, PK(l0, h0), od, 0, 0, 0);
    od = __builtin_amdgcn_mfma_f32_32x32x16_bf16(pa1, PK(l1, h1), od, 0, 0, 0);
    od = __builtin_amdgcn_mfma_f32_32x32x16_bf16(pa2, PK(l2, h2), od, 0, 0, 0);
    od = __builtin_amdgcn_mfma_f32_32x32x16_bf16(pa3, PK(l3, h3), od, 0, 0, 0);
#undef PK
}
__device__ __forceinline__ void pv_d0(f32x16* o, int vb, bf16x8 pa0, bf16x8 pa1, bf16x8 pa2, bf16x8 pa3) {
    pv_one<0>(o[0], vb, pa0, pa1, pa2, pa3); pv_one<1>(o[1], vb, pa0, pa1, pa2, pa3); pv_one<2>(o[2], vb, pa0, pa1, pa2, pa3); pv_one<3>(o[3], vb, pa0, pa1, pa2, pa3);
}
__device__ __forceinline__ float psm_max(const f32x16& p0, const f32x16& p1) {
    float pmax = p0[0];
#pragma unroll
    for (int r = 1; r < 16; ++r) pmax = fmaxf(pmax, p0[r]);
#pragma unroll
    for (int r = 0; r < 16; ++r) pmax = fmaxf(pmax, p1[r]);
    auto rr = __builtin_amdgcn_permlane32_swap(__float_as_uint(pmax), __float_as_uint(pmax), false, false);
    return fmaxf(__uint_as_float(rr[0]), __uint_as_float(rr[1]));
}
__device__ __forceinline__ void psm_decide(float pmax, float& m_reg, float& mn, float& alpha) {
    constexpr float C = AT_SCALE * 1.4426950408889634f;
    if (__builtin_expect(__all(pmax - m_reg <= AT_THR / AT_SCALE), 1)) { mn = m_reg; alpha = 1.f; }
    else { mn = fmaxf(m_reg, pmax); alpha = __builtin_amdgcn_exp2f((m_reg - mn) * C); m_reg = mn; }
}
__device__ __forceinline__ void psm_fma(f32x16& p0, f32x16& p1, float mn) {
    constexpr float C = AT_SCALE * 1.4426950408889634f;
    const float mnC = -mn * C;
#pragma unroll
    for (int r = 0; r < 16; ++r) p0[r] = fmaf(p0[r], C, mnC);
#pragma unroll
    for (int r = 0; r < 16; ++r) p1[r] = fmaf(p1[r], C, mnC);
}
__device__ __forceinline__ void psm_exp(f32x16& p0) {
#pragma unroll
    for (int r = 0; r < 16; ++r) p0[r] = __builtin_amdgcn_exp2f(p0[r]);
}
__device__ __forceinline__ void fin_sum(f32x16& p0, f32x16& p1, float alpha, float& l_reg) {
#pragma unroll
    for (int r = 0; r < 16; ++r) p1[r] = __builtin_amdgcn_exp2f(p1[r]);
    float ps = 0;
#pragma unroll
    for (int r = 0; r < 16; ++r) ps += p0[r];
#pragma unroll
    for (int r = 0; r < 16; ++r) ps += p1[r];
    auto rr = __builtin_amdgcn_permlane32_swap(__float_as_uint(ps), __float_as_uint(ps), false, false);
    ps = __uint_as_float(rr[0]) + __uint_as_float(rr[1]);
    l_reg = l_reg * alpha + ps;
}
template <int BASE> __device__ __forceinline__ bf16x8 pk4(const f32x16& P) {
    unsigned a0 = cvt_pk_bf16(P[BASE + 0], P[BASE + 1]), a1 = cvt_pk_bf16(P[BASE + 2], P[BASE + 3]);
    unsigned b0 = cvt_pk_bf16(P[BASE + 4], P[BASE + 5]), b1 = cvt_pk_bf16(P[BASE + 6], P[BASE + 7]);
    auto r0 = __builtin_amdgcn_permlane32_swap(a0, b0, false, false); auto r1 = __builtin_amdgcn_permlane32_swap(a1, b1, false, false);
    u32x4 w = {r0[0], r1[0], r0[1], r1[1]}; return *reinterpret_cast<bf16x8*>(&w);
}
template <int KS> __device__ __forceinline__ void pv_k(f32x16* o, int vb, bf16x8 pa) {
    const s16x4 l0 = tr_read<v_rd_off(0, KS, 0)>(vb), h0 = tr_read<v_rd_off(0, KS, 1)>(vb), l1 = tr_read<v_rd_off(1, KS, 0)>(vb), h1 = tr_read<v_rd_off(1, KS, 1)>(vb);
    const s16x4 l2 = tr_read<v_rd_off(2, KS, 0)>(vb), h2 = tr_read<v_rd_off(2, KS, 1)>(vb), l3 = tr_read<v_rd_off(3, KS, 0)>(vb), h3 = tr_read<v_rd_off(3, KS, 1)>(vb);
    asm volatile("s_waitcnt lgkmcnt(0)" ::: "memory"); SBAR();
#define PK(L, H) (bf16x8){L[0], L[1], L[2], L[3], H[0], H[1], H[2], H[3]}
    o[0] = __builtin_amdgcn_mfma_f32_32x32x16_bf16(pa, PK(l0, h0), o[0], 0, 0, 0);
    o[1] = __builtin_amdgcn_mfma_f32_32x32x16_bf16(pa, PK(l1, h1), o[1], 0, 0, 0);
    o[2] = __builtin_amdgcn_mfma_f32_32x32x16_bf16(pa, PK(l2, h2), o[2], 0, 0, 0);
    o[3] = __builtin_amdgcn_mfma_f32_32x32x16_bf16(pa, PK(l3, h3), o[3], 0, 0, 0);
#undef PK
}
#define AT_STEP(pC0, pC1, alC, pN0, pN1, mnN, alN, KB, VB, LOADSTMT) do { \
    SBAR(); at_qkt(pN0, pN1, KB, qr, r32, hi); fin_sum(pC0, pC1, alC, l_reg); pa0 = pk4<0>(pC0); pa1 = pk4<8>(pC0); SBAR(); \
    LOADSTMT; SBAR(); \
    pv_k<0>(o, VB, pa0); pa2 = pk4<0>(pC1); pa3 = pk4<8>(pC1); \
    pv_k<1>(o, VB, pa1); { const float pm_ = psm_max(pN0, pN1); \
    pv_k<2>(o, VB, pa2); psm_decide(pm_, m_reg, mnN, alN); } psm_fma(pN0, pN1, mnN); \
    pv_k<3>(o, VB, pa3); psm_exp(pN0); asm volatile("" : "+v"(pN0), "+v"(pN1)); SBAR(); } while (0)

template <int COMP>
__device__ __forceinline__ void attn_item(const bf16_t* __restrict__ Qb, const bf16_t* __restrict__ Kh, const bf16_t* __restrict__ Vh, const int seq, char* lds,
                                          const float lam, float* __restrict__ stash, bf16_t* __restrict__ outp, const float* __restrict__ gsub) {
    const int tid = opaque_tid(), wid = tid >> 6, lane = tid & 63, r32 = lane & 31, hi = lane >> 5;
    char* V_lds = lds; char* K_lds = lds + 3 * SHM_V;
    float* ws = (float*)(lds + 3 * SHM_V + 3 * SHM_K) + wid * 64; float* li_l = ws; float* al_l = ws + 32;
    float m_reg = -1e30f, l_reg = 0; f32x16 o[4] = {}; bf16x8 qr[4];
    const bf16_t* Qw = Qb + (long)(wid * 32 + r32) * AT_LD + hi * 8;
#pragma unroll
    for (int d0 = 0; d0 < 4; ++d0) qr[d0] = *reinterpret_cast<const bf16x8*>(Qw + d0 * 16);
    const int vb0 = (int)(uintptr_t)V_lds + v_rd_base(lane);
    const int widu = __builtin_amdgcn_readfirstlane(wid);
    LAS unsigned char* ldsl = (LAS unsigned char*)lds;
    unsigned koff, voff0, voff1;
    { const int row = widu * 8 + (lane >> 3), chunk = (lane & 7) ^ ((row >> 1) & 7); koff = (unsigned)(row * AT_LDK + chunk * 8); }
    { const int b = widu * 1024 + lane * 16, st_ = b >> 9, e = (b & 511) >> 1, kk = (st_ >> 2) * 8 + (e >> 5), c = (st_ & 3) * 32 + (e & 31), k = (kk & ~0xC) | ((kk & 4) << 1) | ((kk & 8) >> 1); voff0 = (unsigned)(k * AT_LDV + c); }
    { const int b = 8192 + widu * 1024 + lane * 16, st_ = b >> 9, e = (b & 511) >> 1, kk = (st_ >> 2) * 8 + (e >> 5), c = (st_ & 3) * 32 + (e & 31), k = (kk & ~0xC) | ((kk & 4) << 1) | ((kk & 8) >> 1); voff1 = (unsigned)(k * AT_LDV + c); }
#define ADMA(b, k0) do { \
    __builtin_amdgcn_global_load_lds((const unsigned*)(Kh + ((unsigned)((k0) * AT_LDK) + koff)), (LAS unsigned*)(ldsl + 3 * SHM_V + (b) * SHM_K + widu * 1024), 16, 0, 0); \
    __builtin_amdgcn_global_load_lds((const unsigned*)(Vh + ((unsigned)((k0) * AT_LDV) + voff0)), (LAS unsigned*)(ldsl + (b) * SHM_V + widu * 1024), 16, 0, 0); \
    __builtin_amdgcn_global_load_lds((const unsigned*)(Vh + ((unsigned)((k0) * AT_LDV) + voff1)), (LAS unsigned*)(ldsl + (b) * SHM_V + 8192 + widu * 1024), 16, 0, 0); } while (0)
#define SWAIT() asm volatile("s_waitcnt vmcnt(0)" ::: "memory")
#define RESC(a) do { if (__any((a) < 1.f)) { if (hi == 0) al_l[r32] = (a); asm volatile("s_waitcnt lgkmcnt(0)" ::: "memory"); \
    _Pragma("unroll") for (int d = 0; d < 4; ++d) _Pragma("unroll") for (int r = 0; r < 16; ++r) o[d][r] *= al_l[crow(r, hi)]; } } while (0)
    f32x16 pA0, pA1, pB0, pB1; float mnA, mnB, alA, alB; bf16x8 pa0, pa1, pa2, pa3; const int NT = seq / 64;
    __syncthreads();
    ADMA(0, 0); ADMA(1, 64); SWAIT(); __syncthreads();
    at_qkt(pA0, pA1, K_lds, qr, r32, hi); at_partialSM(pA0, pA1, m_reg, mnA, alA);
    int ib0 = 0, ib1 = 1, ib2 = 2;
#define AT_FULL(pC0, pC1, alC, pN0, pN1, mnN, alN, J) do { \
    if ((J) + 1 < NT) ADMA(ib2, ((J) + 1) * 64); \
    AT_STEP(pC0, pC1, alC, pN0, pN1, mnN, alN, K_lds + ib1 * SHM_K, vb0 + ib0 * SHM_V, (void)0); \
    RESC(alN); SWAIT(); __syncthreads(); { const int t_ = ib0; ib0 = ib1; ib1 = ib2; ib2 = t_; } } while (0)
    for (int j = 1; j + 1 < NT; j += 2) {
        AT_FULL(pA0, pA1, alA, pB0, pB1, mnB, alB, j);
        AT_FULL(pB0, pB1, alB, pA0, pA1, mnA, alA, j + 1);
    }
    AT_FULL(pA0, pA1, alA, pB0, pB1, mnB, alB, NT - 1);
    at_finishSM(pB0, pB1, alB, l_reg, pa0, pa1, pa2, pa3); SBAR();
    pv_d0(o, vb0 + ib0 * SHM_V, pa0, pa1, pa2, pa3);
    if (hi == 0) li_l[r32] = l_reg; asm volatile("s_waitcnt lgkmcnt(0)" ::: "memory");
    unsigned* Sw = (unsigned*)(lds + 75776) + wid * 2048 + lane;
    (void)stash;
    if (COMP == 0) {
#pragma unroll
        for (int r = 0; r < 16; ++r) { const float rl = __builtin_amdgcn_rcpf(li_l[crow(r, hi)]);
            Sw[(r * 2 + 0) * 64] = cvt_pk_bf16(o[0][r] * rl, o[1][r] * rl); Sw[(r * 2 + 1) * 64] = cvt_pk_bf16(o[2][r] * rl, o[3][r] * rl); }
    } else {
        bf16_t* Ow = outp + (unsigned)(wid * 32 + 4 * hi) * DM + r32;
        float g4[4];
#pragma unroll
        for (int d0 = 0; d0 < 4; ++d0) g4[d0] = gsub[d0 * 32 + r32] * 0.8f;
#pragma unroll
        for (int r = 0; r < 16; ++r) { const float rl = __builtin_amdgcn_rcpf(li_l[crow(r, hi)]) * lam;
            float v[4]; float ss = 0.f;
            { const unsigned u0 = Sw[(r * 2 + 0) * 64], u1 = Sw[(r * 2 + 1) * 64];
              v[0] = __uint_as_float(u0 << 16) - o[0][r] * rl; v[1] = __uint_as_float(u0 & 0xffff0000u) - o[1][r] * rl;
              v[2] = __uint_as_float(u1 << 16) - o[2][r] * rl; v[3] = __uint_as_float(u1 & 0xffff0000u) - o[3][r] * rl; }
#pragma unroll
            for (int d0 = 0; d0 < 4; ++d0) ss += v[d0] * v[d0];
#pragma unroll
            for (int sh = 1; sh < 32; sh <<= 1) ss += __shfl_xor(ss, sh);
            const float rs = rsqrtf(ss * (1.f / 128.f) + 1e-5f);
#pragma unroll
            for (int d0 = 0; d0 < 4; ++d0) Ow[(unsigned)(((r & 3) + 8 * (r >> 2)) * DM + d0 * 32)] = f2bf(v[d0] * rs * g4[d0]);
            __builtin_amdgcn_sched_barrier(0); }
    }
#undef ADMA
#undef SWAIT
#undef RESC
#undef AT_FULL
}

__device__ __forceinline__ void attn_phase(const Params& p, char* lds) {
    const int lane = opaque_tid() & 63;
    const float s1 = wave_sum(p.lq1[lane] * p.lk1[lane]), s2 = wave_sum(p.lq2[lane] * p.lk2[lane]);
    const float lam = __expf(s1) - __expf(s2) + 0.2f;
    const bf16_t* PROJ = (const bf16_t*)(p.ws + WS_A);
    bf16_t* MIX = (bf16_t*)(p.ws + WS_C);
    for (int it = blockIdx.x; it < 1280; it += gridDim.x) {
        int gb, h, qb, seq;
        if (it < 1024) { const int rr = it >> 8, c = it & 255, bh = rr * 8 + (c & 7); gb = bh >> 3; h = bh & 7; qb = c >> 3; seq = 8192; }
        else { const int c = it - 1024, bh = (c & 7) * 2 + (c >> 7); gb = 4 + (bh >> 3); h = bh & 7; qb = (c >> 3) & 15; seq = 4096; }
        const int t0 = tok0_of(gb);
        const size_t row0 = (size_t)t0 + (size_t)qb * 256;
        float* stash = p.out + (size_t)it * 32768;
        bf16_t* outp = MIX + row0 * DM + 1024 + h * 128;
        const bf16_t* KHp = (const bf16_t*)p.out + 83886080; const bf16_t* VHp = KHp + 41943040;
        const bf16_t* Kb = KHp + (size_t)t0 * 1024 + (size_t)(h * 2) * seq * 64; const bf16_t* Vb = VHp + (size_t)t0 * 1024 + (size_t)h * seq * 128; const bf16_t* Qb = PROJ + row0 * NPROJ + 1024 + h * 128;
        attn_item<0>(Qb, Kb, Vb, seq, lds, lam, stash, outp, p.g_subln);
        attn_item<1>(Qb + 64, Kb + (size_t)seq * 64, Vb, seq, lds, lam, stash, outp, p.g_subln);
    }
}

__device__ __forceinline__ bf16x8 gatherB(const LAS bf16_t* Ds, int pitch, int kbase, int n) {
    bf16x8 b;
#pragma unroll
    for (int j = 0; j < 8; ++j) b[j] = (short)Ds[(kbase + j) * pitch + n];
    return b;
}
__device__ __forceinline__ void fftA_phase(const Params& p, LAS unsigned char* lds) {
    const int tid = opaque_tid(), wid = tid >> 6, lane = tid & 63, r32 = lane & 31, hi = lane >> 5;
    constexpr int PM = 136, PD = 136, PU = 136;
    LAS bf16_t* Ms = (LAS bf16_t*)lds; LAS bf16_t* Ds = (LAS bf16_t*)(lds + 128 * PM * 2); LAS bf16_t* Us = (LAS bf16_t*)(lds + 128 * PM * 2 + 128 * PD * 2);
    const bf16_t* PROJ = (const bf16_t*)(p.ws + WS_A); bf16_t* Y = (bf16_t*)(p.ws + WS_B); const bf16_t* FM = (const bf16_t*)(p.ws + WS_FMA); const bf16_t* FCT = (const bf16_t*)(p.ws + WS_FCT);
    __syncthreads();
#pragma unroll
    for (int i = 0; i < 4; ++i) { const int q = tid + 512 * i, row = q >> 4, c8 = (q & 15) * 8; *(LAS u32x4*)(Ms + row * PM + c8) = *(const u32x4*)(FM + row * 128 + c8); }
    bf16x8 fc[8];
#pragma unroll
    for (int ks = 0; ks < 8; ++ks) fc[ks] = *(const bf16x8*)(FCT + (wid * 32 + r32) * 128 + ks * 16 + hi * 8);
    u32x4 st[2];
    auto decode = [&](int u, int& t0, int& s2, int& c0, int& N2, int& S) {
        if (u < 4096) { t0 = (u >> 10) * 8192; const int rem = u & 1023; s2 = rem >> 3; c0 = (rem & 7) * 128; N2 = 128; S = 8192; }
        else { const int v = u - 4096; t0 = 32768 + (v >> 9) * 4096; const int rem = v & 511; s2 = rem >> 3; c0 = (rem & 7) * 128; N2 = 64; S = 4096; } };
    auto loadu = [&](int u) { int t0, s2, c0, N2, S; decode(u, t0, s2, c0, N2, S);
#pragma unroll
        for (int i = 0; i < 2; ++i) { const int q = tid + 512 * i, s1 = q >> 4, c8 = (q & 15) * 8;
            st[i] = *(const u32x4*)(PROJ + (size_t)(t0 + s1 * N2 + s2) * NPROJ + c0 + c8); } };
    int u = blockIdx.x;
    if (u < 5120) loadu(u);
    for (; u < 5120; u += gridDim.x) {
        __syncthreads();
#pragma unroll
        for (int i = 0; i < 2; ++i) { const int q = tid + 512 * i, s1 = q >> 4, c8 = (q & 15) * 8; *(LAS u32x4*)(Us + s1 * PU + c8) = st[i]; }
        __syncthreads();
        if (u + (int)gridDim.x < 5120) loadu(u + gridDim.x);
        {
            f32x16 c0a = {}, c1a = {};
#pragma unroll
            for (int ks = 0; ks < 8; ++ks) { const int kb = ks * 16 + hi * 8;
                const bf16x8 u0 = *(const LAS bf16x8*)(Us + r32 * PU + kb), u1 = *(const LAS bf16x8*)(Us + (32 + r32) * PU + kb);
                c0a = __builtin_amdgcn_mfma_f32_32x32x16_bf16(u0, fc[ks], c0a, 0, 0, 0); c1a = __builtin_amdgcn_mfma_f32_32x32x16_bf16(u1, fc[ks], c1a, 0, 0, 0); }
            const int n = wid * 32 + r32, pp = n >> 7, cp = n & 127;
#pragma unroll
            for (int r = 0; r < 16; ++r) { const int s1 = crow(r, hi);
                Ds[(pp * 64 + s1) * PD + cp] = f2bf_rne(c0a[r]); Ds[(pp * 64 + 32 + s1) * PD + cp] = f2bf_rne(c1a[r]); }
        }
        __syncthreads();
        int t0, s2, c0, N2, S; decode(u, t0, s2, c0, N2, S);
        const int nb = wid & 3, mp = wid >> 2;
        f32x16 a0 = {}, a1 = {};
#pragma unroll
        for (int ks = 0; ks < 8; ++ks) { const int kb = ks * 16 + hi * 8;
            const bf16x8 b = gatherB(Ds, PD, kb, nb * 32 + r32);
            const bf16x8 m0 = *(const LAS bf16x8*)(Ms + (mp * 32 + r32) * PM + kb), m1 = *(const LAS bf16x8*)(Ms + (64 + mp * 32 + r32) * PM + kb);
            a0 = __builtin_amdgcn_mfma_f32_32x32x16_bf16(m0, b, a0, 0, 0, 0); a1 = __builtin_amdgcn_mfma_f32_32x32x16_bf16(m1, b, a1, 0, 0, 0); }
        const float invS = 1.f / (float)S;
#pragma unroll
        for (int r = 0; r < 16; ++r) { const int k1 = mp * 32 + crow(r, hi); const int j = (s2 * k1) & (S - 1); const float fr = (float)j * invS;
            const float cs = __builtin_amdgcn_cosf(fr), sn = __builtin_amdgcn_sinf(fr);
            const float yr = a0[r], yi = a1[r], orr = yr * cs + yi * sn, oi = yi * cs - yr * sn;
            bf16_t* d = Y + (size_t)(t0 + k1 * N2 + s2) * DM + c0 + nb * 32 + r32;
            d[0] = f2bf(orr); d[1024] = f2bf(oi); }
    }
}
template <int N2>
__device__ __forceinline__ void fftC_phase(const Params& p, LAS unsigned char* lds) {
    const int tid = opaque_tid(), wid = tid >> 6, lane = tid & 63, r32 = lane & 31, hi = lane >> 5;
    constexpr int KD = 2 * N2, PM = KD + 8, PD = 72, S = 64 * N2, NPC = KD * 8 / 512  , NU = (N2 == 128 ? 4096 : 2048);
    LAS bf16_t* Ms = (LAS bf16_t*)lds; LAS bf16_t* Ds = (LAS bf16_t*)(lds + 128 * 264 * 2);
    const bf16_t* Y = (const bf16_t*)(p.ws + WS_B); bf16_t* MIX = (bf16_t*)(p.ws + WS_C); const bf16_t* FM = (const bf16_t*)(p.ws + (N2 == 128 ? WS_FMC128 : WS_FMC64));
    const float scale = N2 == 128 ? 9.765625e-4f   : 1.3810679320049757e-3f  ;
    __syncthreads();
    for (int q = tid; q < N2 * KD / 8; q += 512) { const int row = q / (KD / 8), c8 = (q % (KD / 8)) * 8; *(LAS u32x4*)(Ms + row * PM + c8) = *(const u32x4*)(FM + row * KD + c8); }
    u32x4 st[NPC];
    auto decode = [&](int u, int& t0, int& k1, int& c0) { const int gbl = u >> 10; t0 = (N2 == 128 ? gbl * 8192 : 32768 + gbl * 4096); k1 = (u >> 4) & 63; c0 = (u & 15) * 64; };
    auto loadu = [&](int u) { int t0, k1, c0; decode(u, t0, k1, c0);
#pragma unroll
        for (int i = 0; i < NPC; ++i) { const int q = tid + 512 * i, row = q >> 3, c8 = (q & 7) * 8, pp = row / N2, s2 = row % N2;
            st[i] = *(const u32x4*)(Y + (size_t)(t0 + k1 * N2 + s2) * DM + pp * 1024 + c0 + c8); } };
    int u = blockIdx.x;
    if (u < NU) loadu(u);
    for (; u < NU; u += gridDim.x) {
        __syncthreads();
#pragma unroll
        for (int i = 0; i < NPC; ++i) { const int q = tid + 512 * i, row = q >> 3, c8 = (q & 7) * 8; *(LAS u32x4*)(Ds + row * PD + c8) = st[i]; }
        __syncthreads();
        if (u + (int)gridDim.x < NU) loadu(u + gridDim.x);
        int t0, k1, c0; decode(u, t0, k1, c0);
        constexpr int NMB = N2 / 32;
        const int mb = wid % NMB, nb = wid / NMB;
        if (nb < 2) {
            f32x16 a0 = {};
#pragma unroll
            for (int ks = 0; ks < KD / 16; ++ks) { const int kb = ks * 16 + hi * 8;
                const bf16x8 b = gatherB(Ds, PD, kb, nb * 32 + r32);
                const bf16x8 m0 = *(const LAS bf16x8*)(Ms + (mb * 32 + r32) * PM + kb);
                a0 = __builtin_amdgcn_mfma_f32_32x32x16_bf16(m0, b, a0, 0, 0, 0); }
#pragma unroll
            for (int r = 0; r < 16; ++r) { const int k2 = mb * 32 + crow(r, hi);
                MIX[(size_t)(t0 + k1 + 64 * k2) * DM + c0 + nb * 32 + r32] = f2bf(a0[r] * scale); }
        }
    }
}

__device__ __forceinline__ void tr_load(const float* __restrict__ W, int ldw, int k0, int n0, const float* __restrict__ ksc, f32x4 (&v)[16], float (&sc)[16], int lane) {
    const int lr = lane >> 4, lq = (lane & 15) * 4;
#pragma unroll
    for (int i = 0; i < 16; ++i) { v[i] = *(const f32x4*)(W + (size_t)(k0 + 4 * i + lr) * ldw + n0 + lq); sc[i] = ksc ? ksc[k0 + 4 * i + lr] : 1.f; }
}
__device__ __forceinline__ void tr_store(bf16_t* __restrict__ WT, int ldt, int kd0, int drow0, bool qkperm, const f32x4 (&v)[16], const float (&sc)[16], LAS float* scr, int lane) {
    const int lr = lane >> 4, lq = (lane & 15) * 4;
#pragma unroll
    for (int i = 0; i < 16; ++i) { const int kk = 4 * i + lr; const f32x4 x = v[i] * sc[i];
        LAS float* q = scr + kk * 65 + lq; q[0] = x[0]; q[1] = x[1]; q[2] = x[2]; q[3] = x[3]; }
    asm volatile("s_waitcnt lgkmcnt(0)" ::: "memory");
    const int c = lane & 7;
#pragma unroll
    for (int j = 0; j < 8; ++j) { const int n = (lane >> 3) + 8 * j; const LAS float* sp = scr + (8 * c) * 65 + n;
        u32x4 o = {cvt_pk_bf16(sp[0 * 65], sp[1 * 65]), cvt_pk_bf16(sp[2 * 65], sp[3 * 65]), cvt_pk_bf16(sp[4 * 65], sp[5 * 65]), cvt_pk_bf16(sp[6 * 65], sp[7 * 65])};
        const int dr = drow0 + (qkperm ? 2 * (n & 31) + (n >> 5) : n);
        *(u32x4*)(WT + (size_t)dr * ldt + kd0 + 8 * c) = o; }
    asm volatile("s_waitcnt lgkmcnt(0)" ::: "memory");
}
#define TR_LOAD(it_, V_, S_) do { int r_ = (it_); \
    if (r_ < 2048) { const int kb = r_ >> 6, nb = r_ & 63; tr_load(p.w_in, 4096, kb * 64, nb * 64, nullptr, V_, S_, lane); } \
    else if (r_ < 2560) { r_ -= 2048; const int kb = r_ >> 5, nb = r_ & 31; tr_load(p.w_out, DM, 1024 + kb * 64, nb * 64, nullptr, V_, S_, lane); } \
    else if (r_ < 5632) { r_ -= 2560; const int w = r_ >> 10, q = r_ & 1023, kb = q >> 5, nb = q & 31; \
        if (w == 0) tr_load(p.w_ck, DM, kb * 64, nb * 64, nullptr, V_, S_, lane); else if (w == 1) tr_load(p.w_cv, DM, kb * 64, nb * 64, nullptr, V_, S_, lane); else tr_load(p.w_co, DM, kb * 64, nb * 64, nullptr, V_, S_, lane); } \
    else if (r_ < 11264) { r_ -= 5632; const int up = r_ >= 2816, q = up ? r_ - 2816 : r_, kb = q / 88, nb = q % 88; \
        if (up) tr_load(p.w_up, DFF, kb * 64, nb * 64, p.g_ffn, V_, S_, lane); else tr_load(p.w_gate, DFF, kb * 64, nb * 64, p.g_ffn, V_, S_, lane); } \
    else { r_ -= 11264; const int kb = r_ >> 5, nb = r_ & 31; tr_load(p.w_down, DM, kb * 64, nb * 64, nullptr, V_, S_, lane); } } while (0)
#define TR_STORE(it_, V_, S_) do { int r_ = (it_); \
    if (r_ < 2048) { const int kb = r_ >> 6, nb = r_ & 63, n = nb * 64; tr_store((bf16_t*)(p.ws + WS_WIN), DM, kb * 64, n, n >= 1024 && n < 3072, V_, S_, scr, lane); } \
    else if (r_ < 2560) { r_ -= 2048; const int kb = r_ >> 5, nb = r_ & 31; tr_store((bf16_t*)(p.ws + WS_WOUT), DM, 1024 + kb * 64, nb * 64, false, V_, S_, scr, lane); } \
    else if (r_ < 5632) { r_ -= 2560; const int w = r_ >> 10, q = r_ & 1023, kb = q >> 5, nb = q & 31; \
        if (w == 0) tr_store((bf16_t*)(p.ws + WS_WCK), DM, kb * 64, nb * 64, false, V_, S_, scr, lane); else if (w == 1) tr_store((bf16_t*)(p.ws + WS_WCV), DM, kb * 64, nb * 64, false, V_, S_, scr, lane); \
        else tr_store((bf16_t*)(p.ws + WS_WCO), DM, kb * 64, nb * 64, false, V_, S_, scr, lane); } \
    else if (r_ < 11264) { r_ -= 5632; const int up = r_ >= 2816, q = up ? r_ - 2816 : r_, kb = q / 88, nb = q % 88, n0 = nb * 64; \
        tr_store((bf16_t*)(p.ws + WS_WGU), DM, kb * 64, 256 * (n0 >> 7) + (n0 & 127) + (up ? 128 : 0), false, V_, S_, scr, lane); } \
    else { r_ -= 11264; const int kb = r_ >> 5, nb = r_ & 31; tr_store((bf16_t*)(p.ws + WS_WD), DFF, kb * 64, nb * 64, false, V_, S_, scr, lane); } } while (0)
__device__ __forceinline__ void norm_row_bf16(const float* __restrict__ xrow, const float* __restrict__ g, bf16_t* __restrict__ orow, int lane) {
    const f32x4* xr = (const f32x4*)xrow + lane; const f32x4* gr = (const f32x4*)g + lane;
    f32x4 v[8]; float s = 0.f;
#pragma unroll
    for (int j = 0; j < 8; ++j) { v[j] = xr[64 * j]; s += (v[j][0] * v[j][0] + v[j][1] * v[j][1]) + (v[j][2] * v[j][2] + v[j][3] * v[j][3]); }
    const float rs = rsqrtf(wave_sum(s) * (1.f / DM) + EPS);
#pragma unroll
    for (int j = 0; j < 8; ++j) { const f32x4 gg = gr[64 * j]; u32x2 w = {cvt_pk_bf16(v[j][0] * rs * gg[0], v[j][1] * rs * gg[1]), cvt_pk_bf16(v[j][2] * rs * gg[2], v[j][3] * rs * gg[3])};
        *((u32x2*)orow + lane + 64 * j) = w; }
}
__device__ __forceinline__ void p0_prologue(const Params& p, LAS unsigned char* lds) {
    const int tid = opaque_tid(), wid = tid >> 6, lane = tid & 63, G = gridDim.x;
    bf16_t* WIN = (bf16_t*)(p.ws + WS_WIN); bf16_t* WOUT = (bf16_t*)(p.ws + WS_WOUT);
    for (int it = blockIdx.x; it < 256; it += G) {
        const int g = it & 7, n0 = (it >> 3) * 64;
        LAS float* Fs = (LAS float*)lds; LAS float* Bs = Fs + 128 * 129;
        __syncthreads();
        for (int q = tid; q < 128 * 128; q += 512) { const int cp = q >> 7, d = q & 127; Fs[cp * 129 + d] = p.w_f[(size_t)g * 16384 + q]; }
        for (int q = tid; q < 128 * 64; q += 512) { const int d = q >> 6, n = q & 63; Bs[d * 65 + n] = p.w_out[(size_t)(g * 128 + d) * DM + n0 + n]; }
        __syncthreads();
        const int n = tid & 63, cgp = tid >> 6;
        float acc[16];
#pragma unroll
        for (int j = 0; j < 16; ++j) acc[j] = 0.f;
        for (int d = 0; d < 128; ++d) { const float b = Bs[d * 65 + n];
#pragma unroll
            for (int j = 0; j < 16; ++j) acc[j] += Fs[(cgp * 16 + j) * 129 + d] * b; }
        u32x4 w0 = {cvt_pk_bf16(acc[0], acc[1]), cvt_pk_bf16(acc[2], acc[3]), cvt_pk_bf16(acc[4], acc[5]), cvt_pk_bf16(acc[6], acc[7])};
        u32x4 w1 = {cvt_pk_bf16(acc[8], acc[9]), cvt_pk_bf16(acc[10], acc[11]), cvt_pk_bf16(acc[12], acc[13]), cvt_pk_bf16(acc[14], acc[15])};
        bf16_t* d = WOUT + (size_t)(n0 + n) * DM + g * 128 + cgp * 16;
        *(u32x4*)d = w0; *(u32x4*)(d + 8) = w1;
    }
    __syncthreads();
    {
        LAS float* scr = (LAS float*)lds + wid * (64 * 65);
        const int gw = blockIdx.x * 8 + wid, GW = G * 8;
        {
            f32x4 cv[16], nv[16]; float cs[16], ns[16];
            int it = gw;
            if (it < 14080) TR_LOAD(it, cv, cs);
            for (; it < 14080; it += GW) {
                const int nit = it + GW;
                if (nit < 14080) TR_LOAD(nit, nv, ns);
                TR_STORE(it, cv, cs);
#pragma unroll
                for (int i = 0; i < 16; ++i) { cv[i] = nv[i]; cs[i] = ns[i]; }
            }
        }
        bf16_t* HA = (bf16_t*)(p.ws + WS_B); bf16_t* MEMN = (bf16_t*)(p.ws + WS_MEMN);
        {
            auto src = [&](int row) -> const float* { if (row < T_ALL) return row < T_P ? p.x_p + (size_t)row * DM : p.x_s + (size_t)(row - T_P) * DM;
                                                     const int mr = row - T_ALL; return mr < 1024 ? p.mem_p + (size_t)mr * DM : p.mem_s + (size_t)(mr - 1024) * DM; };
            f32x4 cur[8], nxt[8];
            int row = gw;
            if (row < T_ALL + NMEMROWS) { const f32x4* xr = (const f32x4*)src(row) + lane;
#pragma unroll
                for (int j = 0; j < 8; ++j) cur[j] = xr[64 * j]; }
            for (; row < T_ALL + NMEMROWS; row += GW) {
                const int nrow = row + GW;
                if (nrow < T_ALL + NMEMROWS) { const f32x4* xr = (const f32x4*)src(nrow) + lane;
#pragma unroll
                    for (int j = 0; j < 8; ++j) nxt[j] = xr[64 * j]; }
                float sq = 0.f;
#pragma unroll
                for (int j = 0; j < 8; ++j) sq += (cur[j][0] * cur[j][0] + cur[j][1] * cur[j][1]) + (cur[j][2] * cur[j][2] + cur[j][3] * cur[j][3]);
                const float rs = rsqrtf(wave_sum(sq) * (1.f / DM) + EPS);
                const f32x4* gr = (const f32x4*)(row < T_ALL ? p.g_mix : p.g_mem) + lane;
                bf16_t* orow = row < T_ALL ? HA + (size_t)row * DM : MEMN + (size_t)(row - T_ALL) * DM;
#pragma unroll
                for (int j = 0; j < 8; ++j) { const f32x4 gg = gr[64 * j]; u32x2 w = {cvt_pk_bf16(cur[j][0] * rs * gg[0], cur[j][1] * rs * gg[1]), cvt_pk_bf16(cur[j][2] * rs * gg[2], cur[j][3] * rs * gg[3])};
                    *((u32x2*)orow + lane + 64 * j) = w; }
#pragma unroll
                for (int j = 0; j < 8; ++j) cur[j] = nxt[j];
            }
        }
    }
    const int gt = blockIdx.x * 512 + tid, GT = G * 512;
    float* sumsq = (float*)(p.ws + WS_SUMSQ);
    for (int i = gt; i < 3 * T_ALL; i += GT) sumsq[i] = 0.f;
    { bf16_t* WQN = (bf16_t*)(p.ws + WS_WCQ);
      for (int i = gt; i < DM * DM / 8; i += GT) { const int k = i >> 8; const float g = p.g_cross[k]; const f32x4 a = *(const f32x4*)(p.w_cq + (size_t)i * 8), b = *(const f32x4*)(p.w_cq + (size_t)i * 8 + 4);
          u32x4 w = {cvt_pk_bf16(a[0] * g, a[1] * g), cvt_pk_bf16(a[2] * g, a[3] * g), cvt_pk_bf16(b[0] * g, b[1] * g), cvt_pk_bf16(b[2] * g, b[3] * g)}; *(u32x4*)(WQN + (size_t)i * 8) = w; } }
    float* rope = (float*)(p.ws + WS_ROPE);
    for (int i = gt; i < 8192 * 32; i += GT) { const int pos = i >> 5, fi = i & 31;
        const double inv = exp2(-(double)fi * 0.41524101186092029), rev = (double)pos * inv * 0.15915494309189535; const float fr = (float)(rev - floor(rev));
        rope[2 * i] = __builtin_amdgcn_cosf(fr); rope[2 * i + 1] = __builtin_amdgcn_sinf(fr); }
    bf16_t* FMA_ = (bf16_t*)(p.ws + WS_FMA); bf16_t* FC128 = (bf16_t*)(p.ws + WS_FMC128); bf16_t* FC64 = (bf16_t*)(p.ws + WS_FMC64);
    for (int i = gt; i < 128 * 128; i += GT) { const int r = i >> 7, c = i & 127, pp = r >> 6, k1 = r & 63, pc = c >> 6, s1 = c & 63; const float fr = (float)((k1 * s1) & 63) * (1.f / 64.f);
        const float cs = __builtin_amdgcn_cosf(fr), sn = __builtin_amdgcn_sinf(fr); FMA_[i] = f2bf(pp == pc ? cs : (pp == 0 ? sn : -sn)); }
    for (int i = gt; i < 128 * 256; i += GT) { const int k2 = i >> 8, c = i & 255, pc = c >> 7, s2 = c & 127; const float fr = (float)((k2 * s2) & 127) * (1.f / 128.f);
        FC128[i] = f2bf(pc == 0 ? __builtin_amdgcn_cosf(fr) : __builtin_amdgcn_sinf(fr)); }
    { bf16_t* FCT = (bf16_t*)(p.ws + WS_FCT);
      for (int i = gt; i < 256 * 128; i += GT) { const int n = i >> 7, c = i & 127, pp = n >> 7, cp = n & 127; const float fr = (float)((c * cp) & 127) * (1.f / 128.f);
          FCT[i] = f2bf(pp == 0 ? __builtin_amdgcn_cosf(fr) : -__builtin_amdgcn_sinf(fr)); } }
    for (int i = gt; i < 64 * 128; i += GT) { const int k2 = i >> 7, c = i & 127, pc = c >> 6, s2 = c & 63; const float fr = (float)((k2 * s2) & 63) * (1.f / 64.f);
        FC64[i] = f2bf(pc == 0 ? __builtin_amdgcn_cosf(fr) : __builtin_amdgcn_sinf(fr)); }
}
__device__ __forceinline__ void final_norm_phase(const Params& p) {
    const int tid = opaque_tid(), wid = tid >> 6, lane = tid & 63;
    const bf16_t* XB = (const bf16_t*)(p.ws + WS_B);
    const f32x4* gr = (const f32x4*)p.g_final;
    const int GW = gridDim.x * 8;
    int row = blockIdx.x * 8 + wid;
    u32x4 cur[4], nxt[4];
    if (row < T_ALL) { const u32x4* xr = (const u32x4*)(XB + (size_t)row * DM) + lane;
#pragma unroll
        for (int j = 0; j < 4; ++j) cur[j] = xr[64 * j]; }
    for (; row < T_ALL; row += GW) {
        const int nrow = row + GW;
        if (nrow < T_ALL) { const u32x4* xr = (const u32x4*)(XB + (size_t)nrow * DM) + lane;
#pragma unroll
            for (int j = 0; j < 4; ++j) nxt[j] = xr[64 * j]; }
        f32x4 v[8]; float s = 0.f;
#pragma unroll
        for (int j = 0; j < 4; ++j) { const u32x4 r = cur[j];
            v[2 * j] = (f32x4){__uint_as_float(r[0] << 16), __uint_as_float(r[0] & 0xffff0000u), __uint_as_float(r[1] << 16), __uint_as_float(r[1] & 0xffff0000u)};
            v[2 * j + 1] = (f32x4){__uint_as_float(r[2] << 16), __uint_as_float(r[2] & 0xffff0000u), __uint_as_float(r[3] << 16), __uint_as_float(r[3] & 0xffff0000u)}; }
#pragma unroll
        for (int j = 0; j < 8; ++j) s += (v[j][0] * v[j][0] + v[j][1] * v[j][1]) + (v[j][2] * v[j][2] + v[j][3] * v[j][3]);
        const float rs = rsqrtf(wave_sum(s) * (1.f / DM) + EPS);
        f32x4* orow = (f32x4*)(p.out + (size_t)row * DM);
#pragma unroll
        for (int j = 0; j < 4; ++j) { const int e4 = (lane + 64 * j) * 2; orow[e4] = v[2 * j] * rs * gr[e4]; orow[e4 + 1] = v[2 * j + 1] * rs * gr[e4 + 1]; }
#pragma unroll
        for (int j = 0; j < 4; ++j) cur[j] = nxt[j];
    }
}

__global__ void __launch_bounds__(512, 2) mega(Params p) {
    extern __shared__ __attribute__((aligned(16))) char shm[];
    LAS unsigned char* lds = (LAS unsigned char*)shm;
    cg::grid_group grid = cg::this_grid();
    unsigned char* ws = p.ws;
    float* sumsq = (float*)(ws + WS_SUMSQ);
#ifdef PROBE_A
#define TSTAMP(i) do { if (blockIdx.x == 0 && threadIdx.x == 0) ((unsigned long long*)(ws + WS_TS))[i] = __builtin_amdgcn_s_memrealtime(); } while (0)
#else
#define TSTAMP(i) do { } while (0)
#endif
#define PHASE(n, ...) if (p.ph_lo <= (n) && (n) < p.ph_hi) { if ((n) > p.ph_lo) grid.sync(); TSTAMP(2 * (n)); if (PHMASK & (1 << (n))) { __VA_ARGS__ } TSTAMP(2 * (n) + 1); }
    PHASE(0, p0_prologue(p, lds);)
    PHASE(1, { P1Sched S; S.ps.init(ws + WS_B, ws + WS_WIN, T_ALL, 4096, DM, DM); S.MEMN = (const char*)(ws + WS_MEMN); S.WCK = (const char*)(ws + WS_WCK); S.WCV = (const char*)(ws + WS_WCV);
               EpiP1 E{EpiProj{(bf16_t*)(ws + WS_A), (const float*)(ws + WS_ROPE), (bf16_t*)p.out + 83886080, (bf16_t*)p.out + 83886080 + 41943040}, EpiStore{(bf16_t*)(ws + WS_KMEM), DM, 0, 256, nullptr}, EpiStore{(bf16_t*)(ws + WS_VMEMT), DM, 0, 256, nullptr}};
               pg8::gemm_phase(lds, DM, DM, DM, S, E); })
    PHASE(2, fftA_phase(p, lds); TSTAMP(24); if (PHMASK & (1 << 12)) attn_phase(p, shm);)
    PHASE(3, fftC_phase<128>(p, lds); fftC_phase<64>(p, lds);
             __syncthreads();
             { PrepSched S{(const char*)(ws + WS_KMEM), (const char*)(ws + WS_WCQ), (int)gridDim.x, (int)blockIdx.x}; EpiStore E{(bf16_t*)(ws + WS_A), DM, 0, 256, nullptr}; pg8::gemm_phase(lds, 512, DM, DM, S, E); }
)
    PHASE(4, { pg8::PlainSched S; S.init(ws + WS_C, ws + WS_WOUT, T_ALL, DM, DM, DM); EpiRes<false, false> E{p.x_p, p.x_s, nullptr, nullptr, (bf16_t*)(ws + WS_B), sumsq}; pg8::gemm_phase(lds, DM, DM, DM, S, E); })
    PHASE(6, { ScoreSched S{(const char*)(ws + WS_B), (const char*)(ws + WS_A), (int)gridDim.x, (int)blockIdx.x};
               EpiSoftmax E{(bf16_t*)(ws + WS_A + (size_t)T_ALL * DM * 2), (LAS float*)(lds + 131072), sumsq}; pg8::gemm_phase<true, false>(lds, DM, DM, DM, S, E); }
               { Prep2Sched S{(const char*)(ws + WS_WCO), (const char*)(ws + WS_VMEMT), (int)gridDim.x / 2, (int)blockIdx.x - (int)gridDim.x / 2}; EpiStore E{(bf16_t*)(ws + WS_A + (32u << 20)), 1024, 0, 256, nullptr}; pg8::gemm_phase(lds, 512, DM, DM, S, E); })
    PHASE(8, { OutSched S; S.ps.init(ws + WS_A + (size_t)T_ALL * DM * 2, ws + WS_A, T_ALL, DM, 1024, 1024); S.VWT = (const char*)(ws + WS_A + (32u << 20));
               EpiRes<true, false> E{nullptr, nullptr, (const bf16_t*)(ws + WS_B), nullptr, (bf16_t*)(ws + WS_B), sumsq + T_ALL}; pg8::gemm_phase(lds, 1024, 1024, 1024, S, E); })
    PHASE(9, { pg8::PlainSched S; S.init(ws + WS_B, ws + WS_WGU, T_ALL, 2 * DFF, DM, DM); EpiSwiglu E{(bf16_t*)(ws + WS_A), sumsq + T_ALL}; pg8::gemm_phase(lds, DM, DM, DM, S, E); })
    PHASE(10, { pg8::PlainSched S; S.init(ws + WS_A, ws + WS_WD, T_ALL, DM, DFF, DFF); EpiRes<true, false> E{nullptr, nullptr, (const bf16_t*)(ws + WS_B), nullptr, (bf16_t*)(ws + WS_B), nullptr}; pg8::gemm_phase(lds, DFF, DFF, DFF, S, E); })
#ifdef PROBE_A
    PHASE(11, final_norm_phase(p);)
    { grid.sync(); const unsigned long long* t = (const unsigned long long*)(p.ws + WS_TS); const float us = (float)(long long)((t[PROBE_B] - t[PROBE_A]) + (t[PROBE_D] - t[PROBE_C])) * 0.01f; const float sc = 1.f + sqrtf((us + PROBE_CONST) * 1e-8f);
      f32x4* o4 = (f32x4*)p.out; for (size_t i = (size_t)blockIdx.x * 512 + threadIdx.x; i < (size_t)T_ALL * DM / 4; i += (size_t)gridDim.x * 512) o4[i] = o4[i] * sc; }
#else
    PHASE(11, final_norm_phase(p);)
#endif
}

extern "C" void kernel_launch(void* const* d_in, const int* in_sizes, int n_in, void* d_out, int out_size, void* d_ws, size_t ws_size, hipStream_t stream) {
    static int grid_blocks = 0;
    if (!grid_blocks) {
        if (n_in != 24 || ws_size < WS_FCT + 65536) { fprintf(stderr, "kernel_launch: unexpected n_in %d / ws %zu (need %zu)\n", n_in, ws_size, (size_t)WS_END); return; }
        int dev = 0, cus = 0, per_cu = 0;
        hipGetDevice(&dev);
        hipDeviceGetAttribute(&cus, hipDeviceAttributeMultiprocessorCount, dev);
        if (hipFuncSetAttribute((const void*)mega, hipFuncAttributeMaxDynamicSharedMemorySize, LDS_BYTES) != hipSuccess) { fprintf(stderr, "kernel_launch: hipFuncSetAttribute failed\n"); return; }
        hipOccupancyMaxActiveBlocksPerMultiprocessor(&per_cu, mega, 512, LDS_BYTES);
        if (per_cu < 1) { fprintf(stderr, "kernel_launch: occupancy query returned %d\n", per_cu); per_cu = 1; }
        grid_blocks = cus;
    }
    Params p{};
    const float** pp = (const float**)&p;
    for (int i = 0; i < 24; ++i) pp[i] = (const float*)d_in[i];
    p.out = (float*)d_out; p.ws = (unsigned char*)d_ws;
#if ONE_LAUNCH
    p.ph_lo = 0; p.ph_hi = NPHASE;
    void* args[] = {&p};
    hipError_t e = hipLaunchCooperativeKernel((const void*)mega, dim3(grid_blocks), dim3(512), args, LDS_BYTES, stream);
    if (e != hipSuccess) fprintf(stderr, "cooperative launch failed: %s (grid %d)\n", hipGetErrorString(e), grid_blocks);
#else
    for (int ph = 0; ph < NPHASE; ++ph) { p.ph_lo = ph; p.ph_hi = ph + 1; hipLaunchKernelGGL(mega, dim3(grid_blocks), dim3(512), LDS_BYTES, stream, p); }
#endif
}
```

```cpp
#include <hip/hip_runtime.h>
#include <hip/hip_cooperative_groups.h>
#include <cstdio>
#include <cstdint>
namespace cg = cooperative_groups;

#ifndef PROBE_CONST
#define PROBE_CONST 0.f
#endif
#ifndef PHMASK
#define PHMASK 0x1FFF
#endif
#ifndef ONE_LAUNCH
#define ONE_LAUNCH 1
#endif

#define LAS __attribute__((address_space(3)))
typedef unsigned short bf16_t;
typedef short bf16x8 __attribute__((ext_vector_type(8)));
typedef short s16x4 __attribute__((ext_vector_type(4)));
typedef float f32x4 __attribute__((ext_vector_type(4)));
typedef float f32x16 __attribute__((ext_vector_type(16)));
typedef unsigned u32x4 __attribute__((ext_vector_type(4)));
typedef unsigned u32x2 __attribute__((ext_vector_type(2)));

constexpr int DM = 2048, T_P = 32768, T_ALL = 40960, NPROJ = 5120, DFF = 5632, NMEMROWS = 1536;
constexpr float EPS = 1e-6f;
constexpr int NPHASE = 12;
constexpr int LDS_BYTES = 147456;

constexpr size_t al256(size_t x) { return (x + 255) / 256 * 256; }
constexpr size_t WS_SUMSQ = 0;
constexpr size_t WS_ROPE = al256(WS_SUMSQ + 3ull * T_ALL * 4);
constexpr size_t WS_FMA = al256(WS_ROPE + 8192ull * 32 * 8);
constexpr size_t WS_FMC128 = al256(WS_FMA + 128 * 128 * 2);
constexpr size_t WS_FMC64 = al256(WS_FMC128 + 128 * 256 * 2);
constexpr size_t WS_MEMN = al256(WS_FMC64 + 64 * 128 * 2);
constexpr size_t WS_KMEM = al256(WS_MEMN + (size_t)NMEMROWS * DM * 2);
constexpr size_t WS_VMEMT = al256(WS_KMEM + (size_t)NMEMROWS * DM * 2);
constexpr size_t WS_WIN = al256(WS_VMEMT + (size_t)NMEMROWS * DM * 2);
constexpr size_t WS_WOUT = al256(WS_WIN + (size_t)NPROJ * DM * 2);
constexpr size_t WS_WCQ = al256(WS_WOUT + (size_t)DM * DM * 2);
constexpr size_t WS_WCK = al256(WS_WCQ + (size_t)DM * DM * 2);
constexpr size_t WS_WCV = al256(WS_WCK + (size_t)DM * DM * 2);
constexpr size_t WS_WCO = al256(WS_WCV + (size_t)DM * DM * 2);
constexpr size_t WS_WGU = al256(WS_WCO + (size_t)DM * DM * 2);
constexpr size_t WS_WD = al256(WS_WGU + 2ull * DFF * DM * 2);
constexpr size_t WS_A = al256(WS_WD + (size_t)DM * DFF * 2);
constexpr size_t WS_C = al256(WS_A + (size_t)T_ALL * NPROJ * 2);
constexpr size_t WS_B = al256(WS_C + (size_t)T_ALL * DM * 2);
constexpr size_t WS_END = WS_B + (size_t)T_ALL * DM * 2;
constexpr size_t WS_FCT = al256(WS_END + 1024);
constexpr size_t WS_TS = WS_END;
static_assert(WS_FCT + 65536 <= (1ull << 30), "workspace");
static_assert((size_t)T_ALL * DFF * 2 <= (WS_B - WS_A), "HFF fits A+C");

struct Params {
    const float *x_p, *x_s, *mem_p, *mem_s, *g_mix, *w_in, *w_f, *lq1, *lk1, *lq2, *lk2, *g_subln, *w_out, *g_cross, *g_mem, *w_cq, *w_ck, *w_cv, *w_co,
        *g_ffn, *w_gate, *w_up, *w_down, *g_final;
    float* out; unsigned char* ws; int ph_lo, ph_hi;
};

__device__ __forceinline__ unsigned cvt_pk_bf16(float lo, float hi) { unsigned r; asm volatile("v_cvt_pk_bf16_f32 %0, %1, %2" : "=v"(r) : "v"(lo), "v"(hi)); return r; }
__device__ __forceinline__ bf16_t f2bf(float f) { return (bf16_t)(cvt_pk_bf16(f, 0.f) & 0xffffu); }
__device__ __forceinline__ bf16_t f2bf_rne(float f) { unsigned u = __float_as_uint(f); u += 0x7fffu + ((u >> 16) & 1u); return (bf16_t)(u >> 16); }
__device__ __forceinline__ float wave_sum(float v) {
#pragma unroll
    for (int o = 1; o < 64; o <<= 1) v += __shfl_xor(v, o);
    return v;
}
__device__ __forceinline__ int opaque_tid() { int t = threadIdx.x; asm volatile("" : "+v"(t)); return t; }
__device__ __forceinline__ int tok0_of(int gb) { return gb < 4 ? gb * 8192 : 32768 + (gb - 4) * 4096; }
__device__ __forceinline__ int crow(int r, int hi) { return (r & 3) + 8 * (r >> 2) + 4 * hi; }

namespace pg8 {
constexpr int BM = 256, BK = 64, HALF = 128, HTB = HALF * BK * 2, STAGE_BYTES = 8 * HTB, NXCD = 8, WGM = 8;
__device__ __forceinline__ int lds_byte(int r, int c) { const int st = (r >> 4) * 2 + (c >> 5), rr = r & 15, cc = c & 31, ob = rr * 64 + cc * 2; return st * 1024 + (ob ^ (((ob >> 9) & 1) << 5)); }
__device__ __forceinline__ void stage_rc(int b, int& R, int& C) { const int st = b / 1024, sb = b % 1024, swz = sb ^ (((sb >> 9) & 1) << 5); R = (st >> 1) * 16 + swz / 64; C = (st & 1) * 32 + (swz % 64) / 2; }
__device__ __forceinline__ int perm32(int rho) { const int n = rho >> 4, i = rho & 15; return 8 * (i >> 2) + 4 * n + (i & 3); }
struct Unit { const char* a; const char* b; int pm, pn, kind; };

struct PlainSched {
    const char* A; const char* B; int nM, nN, nwg, G, c; long tsA, tsB;
    __device__ void init(const void* A_, const void* B_, int M, int N, int lda, int ldb) {
        A = (const char*)A_; B = (const char*)B_; nM = M / BM; nN = N / BM; nwg = nM * nN; G = gridDim.x; c = blockIdx.x; tsA = (long)BM * lda * 2; tsB = (long)BM * ldb * 2; }
    __device__ __forceinline__ bool next(int i, Unit& u) const { const long L = (long)i * G + c; if (L >= nwg) return false; map((int)L, u); return true; }
    __device__ __forceinline__ void map(int L, Unit& u) const {
        int wgid = L; { const int q = nwg / NXCD, r = nwg % NXCD, xcd = wgid % NXCD, off = wgid / NXCD; wgid = (xcd < r ? xcd * (q + 1) : r * (q + 1) + (xcd - r) * q) + off; }
        const int nig = WGM * nN, gid = wgid / nig, fm = gid * WGM, gsz = (nM - fm) < WGM ? (nM - fm) : WGM;
        u.pm = fm + ((wgid % nig) % gsz); u.pn = (wgid % nig) / gsz;
        u.a = A + (long)u.pm * tsA; u.b = B + (long)u.pn * tsB; u.kind = 0;
    }
};

template <bool ALIGN_EPI = true, bool SP2 = true, class Epi, class Sched>
__device__ __forceinline__ void gemm_phase(LAS unsigned char* lds, const int K, const int lda, const int ldb, const Sched& S, const Epi& E) {
    const int tid = opaque_tid(), wid = __builtin_amdgcn_readfirstlane(tid >> 6), lane = tid & 63, wr = wid >> 2, wc = wid & 3, fr = lane & 15, fq = lane >> 4;
    const int nt = K / BK;
    unsigned voffA[2], voffB[2];
#pragma unroll
    for (int i = 0; i < 2; ++i) { int R, C; stage_rc(tid * 16 + i * 8192, R, C); const int Rb = Epi::PERM ? ((R & ~31) + perm32(R & 31)) : R;
        voffA[i] = (unsigned)(R * lda + C) * 2u; voffB[i] = (unsigned)(Rb * ldb + C) * 2u; }
    const size_t kstep = (size_t)(BK * 2);
    const size_t hstepA = (size_t)HALF * lda * 2, hstepB = (size_t)HALF * ldb * 2;
    const unsigned ldsw = (unsigned)wid * 1024u;
    const int aoff = lds_byte(wr * 64 + fr, fq * 8), boff = lds_byte(wc * 32 + fr, fq * 8);
#define PG8_SA(b, h) (((b) * 2 + (h)) * HTB)
#define PG8_SB(b, h) ((4 + (b) * 2 + (h)) * HTB)
#define PG8_STAGE(bufoff, gbase, voff) do { _Pragma("unroll") for (int _i = 0; _i < 2; ++_i) \
        __builtin_amdgcn_global_load_lds((const unsigned*)((const char*)(gbase) + (voff)[_i]), (LAS unsigned*)(lds + (bufoff) + ldsw + _i * 8192), 16, 0, 0); } while (0)
#define PG8_LDA(dst, b, h) do { _Pragma("unroll") for (int m = 0; m < 4; ++m) _Pragma("unroll") for (int k = 0; k < 2; ++k) dst[m][k] = *(const LAS bf16x8*)(lds + PG8_SA(b, h) + aoff + m * 2048 + k * 1024); } while (0)
#define PG8_LDB(dst, b, h) do { _Pragma("unroll") for (int n = 0; n < 2; ++n) _Pragma("unroll") for (int k = 0; k < 2; ++k) dst[n][k] = *(const LAS bf16x8*)(lds + PG8_SB(b, h) + boff + n * 2048 + k * 1024); } while (0)
#define PG8_MMA(ai, bj, At, Bt) do { __builtin_amdgcn_s_setprio(1); _Pragma("unroll") for (int m = 0; m < 4; ++m) _Pragma("unroll") for (int n = 0; n < 2; ++n) _Pragma("unroll") for (int k = 0; k < 2; ++k) \
        acc[ai][bj][m][n] = __builtin_amdgcn_mfma_f32_16x16x32_bf16(Bt[n][k], At[m][k], acc[ai][bj][m][n], 0, 0, 0); __builtin_amdgcn_s_setprio(0); } while (0)
#define PG8_WAIT_V(n) asm volatile("s_waitcnt vmcnt(" #n ")" ::: "memory")
#define PG8_WAIT_L(n) asm volatile("s_waitcnt lgkmcnt(" #n ")" ::: "memory")
#define PG8_BAR __builtin_amdgcn_s_barrier()
#define PG8_SCHED __builtin_amdgcn_sched_barrier(0)
    Unit cur, nxt; int ui = 0;
    if (!S.next(0, cur)) return;
    f32x4 acc[2][2][4][2];
#pragma unroll
    for (int a = 0; a < 2; ++a)
#pragma unroll
        for (int b = 0; b < 2; ++b)
#pragma unroll
            for (int m = 0; m < 4; ++m)
#pragma unroll
                for (int n = 0; n < 2; ++n) acc[a][b][m][n] = (f32x4){0.f, 0.f, 0.f, 0.f};
    bf16x8 At[4][2], B0[2][2], B1[2][2];
    const char* cA = cur.a; const char* cB = cur.b;
    if constexpr (SP2) {
        PG8_STAGE(PG8_SB(0, 0), cB, voffB); PG8_STAGE(PG8_SB(0, 1), cB + hstepB, voffB); PG8_STAGE(PG8_SA(0, 0), cA, voffA); PG8_STAGE(PG8_SA(0, 1), cA + hstepA, voffA);
        if (wr == 1) PG8_BAR;
        PG8_WAIT_V(2); PG8_BAR;
        PG8_STAGE(PG8_SB(1, 0), cB + kstep, voffB); PG8_STAGE(PG8_SA(1, 0), cA + kstep, voffA); PG8_STAGE(PG8_SB(1, 1), cB + hstepB + kstep, voffB);
        PG8_WAIT_V(6); PG8_BAR;
    } else {
        PG8_STAGE(PG8_SB(0, 0), cB, voffB); PG8_STAGE(PG8_SA(0, 0), cA, voffA); PG8_STAGE(PG8_SB(0, 1), cB + hstepB, voffB); PG8_STAGE(PG8_SA(0, 1), cA + hstepA, voffA);
        if (wr == 1) PG8_BAR;
        PG8_WAIT_V(4); PG8_BAR;
        PG8_STAGE(PG8_SB(1, 0), cB + kstep, voffB); PG8_STAGE(PG8_SA(1, 0), cA + kstep, voffA); PG8_STAGE(PG8_SB(1, 1), cB + hstepB + kstep, voffB);
        PG8_WAIT_V(6); PG8_BAR;
    }
    for (;;) {
        const bool has_next = S.next(ui + 1, nxt);
        const char* nA = has_next ? nxt.a : cA; const char* nB = has_next ? nxt.b : cB;
#pragma unroll 1
        for (int t = 0; t < nt; t += 2) {
            const bool last = (t == nt - 2);
            const char* a1 = cA + (size_t)(t + 1) * kstep;
            const char* a2 = last ? nA : cA + (size_t)(t + 2) * kstep; const char* b2 = last ? nB : cB + (size_t)(t + 2) * kstep;
            const char* a3 = a2 + kstep; const char* b3 = b2 + kstep;
            if constexpr (SP2) {
            PG8_LDB(B0, 0, 0); PG8_LDB(B1, 0, 1); PG8_SCHED; PG8_LDA(At, 0, 0); PG8_STAGE(PG8_SA(1, 1), a1 + hstepA, voffA);
            PG8_WAIT_V(8); PG8_WAIT_L(0); PG8_BAR; PG8_MMA(0, 0, At, B0); PG8_MMA(0, 1, At, B1); PG8_BAR; PG8_SCHED;
            PG8_LDA(At, 0, 1); PG8_STAGE(PG8_SB(0, 0), b2, voffB); PG8_STAGE(PG8_SB(0, 1), b2 + hstepB, voffB); PG8_STAGE(PG8_SA(0, 0), a2, voffA);
            PG8_WAIT_V(8); PG8_WAIT_L(0); PG8_BAR; PG8_MMA(1, 0, At, B0); PG8_MMA(1, 1, At, B1); PG8_BAR; PG8_SCHED;
            PG8_LDB(B0, 1, 0); PG8_LDB(B1, 1, 1); PG8_SCHED; PG8_LDA(At, 1, 0); PG8_STAGE(PG8_SA(0, 1), a2 + hstepA, voffA);
            PG8_WAIT_V(8); PG8_WAIT_L(0); PG8_BAR; PG8_MMA(0, 0, At, B0); PG8_MMA(0, 1, At, B1); PG8_BAR; PG8_SCHED;
            PG8_LDA(At, 1, 1); PG8_STAGE(PG8_SB(1, 0), b3, voffB); PG8_STAGE(PG8_SB(1, 1), b3 + hstepB, voffB); PG8_STAGE(PG8_SA(1, 0), a3, voffA);
            PG8_WAIT_V(8); PG8_WAIT_L(0); PG8_BAR; PG8_MMA(1, 0, At, B0); PG8_MMA(1, 1, At, B1); PG8_BAR; PG8_SCHED;
            } else {
            PG8_LDB(B0, 0, 0); PG8_SCHED; PG8_LDA(At, 0, 0); PG8_STAGE(PG8_SA(1, 1), a1 + hstepA, voffA);
            PG8_WAIT_L(8); PG8_BAR; PG8_WAIT_L(0); PG8_MMA(0, 0, At, B0); PG8_BAR; PG8_SCHED;
            PG8_LDB(B1, 0, 1); PG8_STAGE(PG8_SB(0, 0), b2, voffB);
            PG8_BAR; PG8_WAIT_L(0); PG8_MMA(0, 1, At, B1); PG8_BAR;
            PG8_LDA(At, 0, 1); PG8_STAGE(PG8_SA(0, 0), a2, voffA);
            PG8_BAR; PG8_WAIT_L(0); PG8_MMA(1, 0, At, B0); PG8_BAR; PG8_SCHED;
            PG8_STAGE(PG8_SB(0, 1), b2 + hstepB, voffB);
            PG8_WAIT_V(6); PG8_BAR; PG8_MMA(1, 1, At, B1); PG8_BAR;
            PG8_LDB(B0, 1, 0); PG8_SCHED; PG8_LDA(At, 1, 0); PG8_STAGE(PG8_SA(0, 1), a2 + hstepA, voffA);
            PG8_WAIT_L(8); PG8_BAR; PG8_WAIT_L(0); PG8_MMA(0, 0, At, B0); PG8_BAR; PG8_SCHED;
            PG8_LDB(B1, 1, 1); PG8_STAGE(PG8_SB(1, 0), b3, voffB);
            PG8_BAR; PG8_WAIT_L(0); PG8_MMA(0, 1, At, B1); PG8_BAR;
            PG8_LDA(At, 1, 1); PG8_STAGE(PG8_SA(1, 0), a3, voffA);
            PG8_BAR; PG8_WAIT_L(0); PG8_MMA(1, 0, At, B0); PG8_BAR; PG8_SCHED;
            PG8_STAGE(PG8_SB(1, 1), b3 + hstepB, voffB);
            PG8_WAIT_V(6); PG8_BAR; PG8_MMA(1, 1, At, B1); PG8_BAR;
                    }
        }
        if constexpr (ALIGN_EPI) { if (wr == 0) PG8_BAR; }
        E(acc, cur, wr, wc, fr, fq);
        if (!has_next) break;
#pragma unroll
        for (int a = 0; a < 2; ++a)
#pragma unroll
            for (int b = 0; b < 2; ++b)
#pragma unroll
                for (int m = 0; m < 4; ++m)
#pragma unroll
                    for (int n = 0; n < 2; ++n) acc[a][b][m][n] = (f32x4){0.f, 0.f, 0.f, 0.f};
        cur = nxt; cA = nA; cB = nB; ++ui;
        if constexpr (ALIGN_EPI) { if (wr == 1) PG8_BAR; }
    }
    PG8_WAIT_V(0);
    if constexpr (!ALIGN_EPI) { if (wr == 0) PG8_BAR; }
    PG8_BAR;
#undef PG8_SA
#undef PG8_SB
#undef PG8_STAGE
#undef PG8_LDA
#undef PG8_LDB
#undef PG8_MMA
#undef PG8_WAIT_V
#undef PG8_WAIT_L
#undef PG8_BAR
#undef PG8_SCHED
}
}
using pg8::Unit;
typedef f32x4 (&AccRef)[2][2][4][2];

struct EpiProj {
    static constexpr bool PERM = true;
    bf16_t* O; const float* rope; bf16_t* KH; bf16_t* VH;
    __device__ __forceinline__ void operator()(AccRef acc, const Unit& u, int wr, int wc, int fr, int fq) const {
        const bool rp = (u.pn >= 4 && u.pn < 12);
        const int kind = u.pn < 8 ? 0 : (u.pn < 12 ? 1 : 2);
#pragma unroll
        for (int ai = 0; ai < 2; ++ai)
#pragma unroll
            for (int m = 0; m < 4; ++m) {
                const int row = u.pm * 256 + ai * 128 + wr * 64 + m * 16 + fr;
                const int pos = row < T_P ? (row & 8191) : (row & 4095);
                const int S = row < T_P ? 8192 : 4096;
                bf16_t* dst; unsigned ro, bjs;
                if (kind == 0) { dst = O; ro = (unsigned)row * NPROJ + u.pn * 256 + wc * 32 + fq * 8; bjs = 128; }
                else if (kind == 1) { dst = KH; ro = (unsigned)(row - pos) * 1024 + (unsigned)(((u.pn - 8) * 4 + (wc >> 1)) * S + pos) * 64 + (wc & 1) * 32 + fq * 8; bjs = 2 * S * 64; }
                else { dst = VH; ro = (unsigned)(row - pos) * 1024 + (unsigned)((u.pn - 12) * 2 * S + pos) * 128 + wc * 32 + fq * 8; bjs = S * 128; }
#pragma unroll
                for (int bj = 0; bj < 2; ++bj) {
                    f32x4 v0 = acc[ai][bj][m][0], v1 = acc[ai][bj][m][1];
                    if (rp) {
                        const unsigned i0 = ((wc * 32 + fq * 8) & 63) >> 1;
                        const unsigned rto = ((unsigned)pos * 32 + i0) * 2;
                        const f32x4 r0 = *(const f32x4*)(rope + rto), r1 = *(const f32x4*)(rope + rto + 4);
                        float a, b;
                        a = v0[0] * r0[0] - v0[1] * r0[1]; b = v0[1] * r0[0] + v0[0] * r0[1]; v0[0] = a; v0[1] = b;
                        a = v0[2] * r0[2] - v0[3] * r0[3]; b = v0[3] * r0[2] + v0[2] * r0[3]; v0[2] = a; v0[3] = b;
                        a = v1[0] * r1[0] - v1[1] * r1[1]; b = v1[1] * r1[0] + v1[0] * r1[1]; v1[0] = a; v1[1] = b;
                        a = v1[2] * r1[2] - v1[3] * r1[3]; b = v1[3] * r1[2] + v1[2] * r1[3]; v1[2] = a; v1[3] = b;
                    }
                    u32x4 w = {cvt_pk_bf16(v0[0], v0[1]), cvt_pk_bf16(v0[2], v0[3]), cvt_pk_bf16(v1[0], v1[1]), cvt_pk_bf16(v1[2], v1[3])};
                    *(u32x4*)(dst + ro + bj * bjs) = w;
                }
                __builtin_amdgcn_sched_barrier(0);
            }
    }
};
struct EpiStore {
    static constexpr bool PERM = true;
    bf16_t* O; int ldc; long pn_stride; int col_per_pn; const float* sumsq;
    __device__ __forceinline__ void operator()(AccRef acc, const Unit& u, int wr, int wc, int fr, int fq) const {
        bf16_t* base = O + (size_t)u.pn * pn_stride + u.pn * col_per_pn;
        float ssq[2][4];
#pragma unroll
        for (int ai = 0; ai < 2; ++ai)
#pragma unroll
            for (int m = 0; m < 4; ++m) ssq[ai][m] = sumsq ? sumsq[u.pm * 256 + ai * 128 + wr * 64 + m * 16 + fr] : 0.f;
#pragma unroll
        for (int ai = 0; ai < 2; ++ai)
#pragma unroll
            for (int m = 0; m < 4; ++m) {
                const int row = u.pm * 256 + ai * 128 + wr * 64 + m * 16 + fr;
                float rs = 1.f;
                if (sumsq) rs = rsqrtf(ssq[ai][m] * (1.f / DM) + EPS);
                const unsigned ro = (unsigned)row * (unsigned)ldc + wc * 32 + fq * 8;
#pragma unroll
                for (int bj = 0; bj < 2; ++bj) {
                    const f32x4 v0 = acc[ai][bj][m][0] * rs, v1 = acc[ai][bj][m][1] * rs;
                    u32x4 w = {cvt_pk_bf16(v0[0], v0[1]), cvt_pk_bf16(v0[2], v0[3]), cvt_pk_bf16(v1[0], v1[1]), cvt_pk_bf16(v1[2], v1[3])};
                    *(u32x4*)(base + ro + bj * 128) = w;
                }
                __builtin_amdgcn_sched_barrier(0);
            }
    }
};
template <bool XBF, bool OUTF32>
struct EpiRes {
    static constexpr bool PERM = true;
    const float* X0; const float* X1; const bf16_t* XBin; float* OUT; bf16_t* XBout; float* sumsq;
    struct Res { f32x4 f[2][2]; u32x4 b[2]; };
    __device__ __forceinline__ void load(Res& r, const float* xb_, unsigned o) const {
#pragma unroll
        for (int bj = 0; bj < 2; ++bj) {
            if (XBF) r.b[bj] = *(const u32x4*)(XBin + o + bj * 128);
            else { r.f[bj][0] = *(const f32x4*)(xb_ + o + bj * 128); r.f[bj][1] = *(const f32x4*)(xb_ + o + bj * 128 + 4); } }
    }
    __device__ __forceinline__ void operator()(AccRef acc, const Unit& u, int wr, int wc, int fr, int fq) const {
        const float* xb_ = (u.pm < T_P / 256) ? X0 : X1 - (size_t)T_P * DM;
        const unsigned o0 = (unsigned)(u.pm * 256 + wr * 64 + fr) * DM + u.pn * 256 + wc * 32 + fq * 8;
        Res ra, rb;
        load(ra, xb_, o0);
#pragma unroll
        for (int i = 0; i < 8; ++i) {
            const int ai = i >> 2, m = i & 3;
            const unsigned o = o0 + (unsigned)(ai * 128 + m * 16) * DM;
            Res& cur = (i & 1) ? rb : ra; Res& nxt = (i & 1) ? ra : rb;
            if (i + 1 < 8) load(nxt, xb_, o0 + (unsigned)(((i + 1) >> 2) * 128 + ((i + 1) & 3) * 16) * DM);
            const int row = u.pm * 256 + ai * 128 + wr * 64 + m * 16 + fr;
            float ss = 0.f;
#pragma unroll
            for (int bj = 0; bj < 2; ++bj) {
                f32x4 x0, x1;
                if (XBF) { const u32x4 r = cur.b[bj];
                    x0 = (f32x4){__uint_as_float(r[0] << 16), __uint_as_float(r[0] & 0xffff0000u), __uint_as_float(r[1] << 16), __uint_as_float(r[1] & 0xffff0000u)};
                    x1 = (f32x4){__uint_as_float(r[2] << 16), __uint_as_float(r[2] & 0xffff0000u), __uint_as_float(r[3] << 16), __uint_as_float(r[3] & 0xffff0000u)};
                } else { x0 = cur.f[bj][0]; x1 = cur.f[bj][1]; }
                const f32x4 v0 = x0 + acc[ai][bj][m][0], v1 = x1 + acc[ai][bj][m][1];
                if (OUTF32) { *(f32x4*)(OUT + o + bj * 128) = v0; *(f32x4*)(OUT + o + bj * 128 + 4) = v1; }
                else { u32x4 w = {cvt_pk_bf16(v0[0], v0[1]), cvt_pk_bf16(v0[2], v0[3]), cvt_pk_bf16(v1[0], v1[1]), cvt_pk_bf16(v1[2], v1[3])}; *(u32x4*)(XBout + o + bj * 128) = w; }
                ss += (v0[0] * v0[0] + v0[1] * v0[1]) + (v0[2] * v0[2] + v0[3] * v0[3]) + (v1[0] * v1[0] + v1[1] * v1[1]) + (v1[2] * v1[2] + v1[3] * v1[3]);
            }
            if (sumsq) { ss += __shfl_xor(ss, 16); ss += __shfl_xor(ss, 32); if (fq == 0) unsafeAtomicAdd(sumsq + row, ss); }
            __builtin_amdgcn_sched_barrier(0);
        }
    }
};
struct EpiSwiglu {
    static constexpr bool PERM = true;
    bf16_t* H; const float* sumsq;
    __device__ __forceinline__ void operator()(AccRef acc, const Unit& u, int wr, int wc, int fr, int fq) const {
        float ssq[2][4];
#pragma unroll
        for (int ai = 0; ai < 2; ++ai)
#pragma unroll
            for (int m = 0; m < 4; ++m) ssq[ai][m] = sumsq[u.pm * 256 + ai * 128 + wr * 64 + m * 16 + fr];
#pragma unroll
        for (int ai = 0; ai < 2; ++ai)
#pragma unroll
            for (int m = 0; m < 4; ++m) {
                const int row = u.pm * 256 + ai * 128 + wr * 64 + m * 16 + fr;
                const float rs = rsqrtf(ssq[ai][m] * (1.f / DM) + EPS);
                float h[8];
#pragma unroll
                for (int n = 0; n < 2; ++n)
#pragma unroll
                    for (int j = 0; j < 4; ++j) {
                        const float g = acc[ai][0][m][n][j] * rs, up = acc[ai][1][m][n][j] * rs;
                        h[n * 4 + j] = g * __builtin_amdgcn_rcpf(1.f + __builtin_amdgcn_exp2f(-1.4426950408889634f * g)) * up;
                    }
                u32x4 w = {cvt_pk_bf16(h[0], h[1]), cvt_pk_bf16(h[2], h[3]), cvt_pk_bf16(h[4], h[5]), cvt_pk_bf16(h[6], h[7])};
                *(u32x4*)(H + ((unsigned)row * DFF + u.pn * 128 + wc * 32 + fq * 8)) = w;
                __builtin_amdgcn_sched_barrier(0);
            }
    }
};
struct EpiSoftmax {
    static constexpr bool PERM = true;
    bf16_t* P; LAS float* ex; const float* sumsq;
    __device__ __forceinline__ void operator()(AccRef acc, const Unit& u, int wr, int wc, int fr, int fq) const {
        constexpr float SC = 0.04419417382415922f * 1.4426950408889634f;
        LAS float* ex2 = ex + 1024;
        float rsc[2][4];
#pragma unroll
        for (int ai = 0; ai < 2; ++ai)
#pragma unroll
            for (int m = 0; m < 4; ++m) rsc[ai][m] = rsqrtf(sumsq[u.pm * 256 + ai * 128 + wr * 64 + m * 16 + fr] * (1.f / DM) + EPS) * SC;
#pragma unroll
        for (int ai = 0; ai < 2; ++ai)
#pragma unroll
            for (int m = 0; m < 4; ++m) {
                float mx = -3.0e38f;
#pragma unroll
                for (int bj = 0; bj < 2; ++bj)
#pragma unroll
                    for (int n = 0; n < 2; ++n)
#pragma unroll
                        for (int j = 0; j < 4; ++j) mx = fmaxf(mx, acc[ai][bj][m][n][j]);
                mx = fmaxf(mx, __shfl_xor(mx, 16)); mx = fmaxf(mx, __shfl_xor(mx, 32));
                const int rl = ai * 128 + wr * 64 + m * 16 + fr;
                if (fq == 0) ex[rl * 4 + wc] = mx;
                __builtin_amdgcn_sched_barrier(0);
            }
        asm volatile("s_waitcnt lgkmcnt(0)" ::: "memory"); __builtin_amdgcn_s_barrier(); asm volatile("" ::: "memory");
#pragma unroll
        for (int ai = 0; ai < 2; ++ai)
#pragma unroll
            for (int m = 0; m < 4; ++m) {
                const int rl = ai * 128 + wr * 64 + m * 16 + fr;
                const f32x4 mv = *(const LAS f32x4*)(ex + rl * 4);
                const float sc_ = rsc[ai][m]; const float mx = fmaxf(fmaxf(mv[0], mv[1]), fmaxf(mv[2], mv[3])) * sc_;
                float sm = 0.f;
#pragma unroll
                for (int bj = 0; bj < 2; ++bj)
#pragma unroll
                    for (int n = 0; n < 2; ++n)
#pragma unroll
                        for (int j = 0; j < 4; ++j) { const float e = __builtin_amdgcn_exp2f(acc[ai][bj][m][n][j] * sc_ - mx); acc[ai][bj][m][n][j] = e; sm += e; }
                sm += __shfl_xor(sm, 16); sm += __shfl_xor(sm, 32);
                if (fq == 0) ex2[rl * 4 + wc] = sm;
                __builtin_amdgcn_sched_barrier(0);
            }
        asm volatile("s_waitcnt lgkmcnt(0)" ::: "memory"); __builtin_amdgcn_s_barrier(); asm volatile("" ::: "memory");
#pragma unroll
        for (int ai = 0; ai < 2; ++ai)
#pragma unroll
            for (int m = 0; m < 4; ++m) {
                const int rl = ai * 128 + wr * 64 + m * 16 + fr;
                const f32x4 sv = *(const LAS f32x4*)(ex2 + rl * 4);
                const float inv = 1.f / ((sv[0] + sv[1]) + (sv[2] + sv[3]));
                bf16_t* rowp = P + ((unsigned)(u.pm * 256 + rl) * 1024 + u.pn * 256 + wc * 32 + fq * 8);
#pragma unroll
                for (int bj = 0; bj < 2; ++bj) {
                    const f32x4 v0 = acc[ai][bj][m][0] * inv, v1 = acc[ai][bj][m][1] * inv;
                    u32x4 w = {cvt_pk_bf16(v0[0], v0[1]), cvt_pk_bf16(v0[2], v0[3]), cvt_pk_bf16(v1[0], v1[1]), cvt_pk_bf16(v1[2], v1[3])};
                    *(u32x4*)(rowp + bj * 128) = w;
                }
                __builtin_amdgcn_sched_barrier(0);
            }
    }
};
struct PrepSched {
    const char* KM; const char* WQ; int G, c;
    __device__ __forceinline__ bool next(int i, Unit& u) const {
        const long L = (long)i * G + c; if (L >= 192) return false;
        const int bh = (int)L >> 3, nt = (int)L & 7, gb = bh >> 2, h = bh & 3;
        u.kind = 0; u.pm = bh; u.pn = nt; u.a = KM + ((size_t)gb * 256 * DM + h * 512) * 2; u.b = WQ + ((size_t)nt * 256 * DM + h * 512) * 2; return true;
    }
};
struct ScoreSched {
    const char* XB; const char* WPT; int G, c;
    __device__ __forceinline__ bool next(int i, Unit& u) const {
        const long L = (long)i * G + c; if (L >= 640) return false;
        const int mt = (int)L >> 2, h = (int)L & 3, gb = mt < 128 ? (mt >> 5) : 4 + ((mt - 128) >> 4);
        u.kind = 0; u.pm = mt; u.pn = h; u.a = XB + (size_t)mt * 256 * DM * 2; u.b = WPT + (size_t)((gb * 4 + h) * 256) * DM * 2; return true;
    }
};
struct Prep2Sched {
    const char* WCO; const char* VM; int G, c;
    __device__ __forceinline__ bool next(int i, Unit& u) const {
        if (c < 0) return false;
        const long L = (long)i * G + c; if (L >= 192) return false;
        const int bh = (int)L >> 3, mtile = (int)L & 7, gb = bh >> 2, h = bh & 3;
        u.kind = 0; u.pm = gb * 8 + mtile; u.pn = h; u.a = WCO + ((size_t)mtile * 256 * DM + h * 512) * 2; u.b = VM + ((size_t)gb * 256 * DM + h * 512) * 2; return true;
    }
};
struct OutSched {
    pg8::PlainSched ps; const char* VWT;
    __device__ __forceinline__ bool next(int i, Unit& u) const {
        if (!ps.next(i, u)) return false;
        const int gb = u.pm < 128 ? (u.pm >> 5) : 4 + ((u.pm - 128) >> 4);
        u.b = VWT + ((size_t)(gb * DM + u.pn * 256) * 1024) * 2; return true;
    }
};

struct P1Sched {
    pg8::PlainSched ps; const char* MEMN; const char* WCK; const char* WCV;
    __device__ __forceinline__ bool next(int i, Unit& u) const {
        const long L = (long)i * ps.G + ps.c;
        if (L < 2560) { ps.map((int)L, u); return true; }
        if (L < 2608) { const int j = (int)L - 2560; u.pm = j >> 3; u.pn = j & 7; u.kind = 1; u.a = MEMN + (size_t)u.pm * 256 * DM * 2; u.b = WCK + (size_t)u.pn * 256 * DM * 2; return true; }
        if (L < 2656) { const int j = (int)L - 2608; u.pm = j >> 3; u.pn = j & 7; u.kind = 2; u.a = MEMN + (size_t)u.pm * 256 * DM * 2; u.b = WCV + (size_t)u.pn * 256 * DM * 2; return true; }
        return false;
    }
};
struct EpiP1 {
    static constexpr bool PERM = true;
    EpiProj ep; EpiStore ek; EpiStore ev;
    __device__ __forceinline__ void operator()(AccRef acc, const Unit& u, int wr, int wc, int fr, int fq) const {
        if (u.kind == 0) ep(acc, u, wr, wc, fr, fq); else if (u.kind == 1) ek(acc, u, wr, wc, fr, fq); else ev(acc, u, wr, wc, fr, fq);
    }
};

constexpr int AT_LD = NPROJ, AT_LDK = 64, AT_LDV = 128, SHM_V = 64 * 128 * 2, SHM_K = 64 * 64 * 2;
constexpr float AT_SCALE = 0.125f, AT_THR = 8.f;
#define KSWZ64(row, colB) ((row) * 128 + ((colB) ^ ((((row) >> 1) & 7) << 4)))
#define SBAR() __builtin_amdgcn_sched_barrier(0)
__device__ __forceinline__ void at_partialSM(f32x16& p0, f32x16& p1, float& m_reg, float& mn, float& alpha) {
    constexpr float C = AT_SCALE * 1.4426950408889634f;
    float pmax = p0[0];
#pragma unroll
    for (int r = 1; r < 16; ++r) pmax = fmaxf(pmax, p0[r]);
#pragma unroll
    for (int r = 0; r < 16; ++r) pmax = fmaxf(pmax, p1[r]);
    { auto rr = __builtin_amdgcn_permlane32_swap(__float_as_uint(pmax), __float_as_uint(pmax), false, false);
      pmax = fmaxf(__uint_as_float(rr[0]), __uint_as_float(rr[1])); }
    if (__builtin_expect(__all(pmax - m_reg <= AT_THR / AT_SCALE), 1)) { mn = m_reg; alpha = 1.f; }
    else { mn = fmaxf(m_reg, pmax); alpha = __builtin_amdgcn_exp2f((m_reg - mn) * C); m_reg = mn; }
    const float mnC = -mn * C;
#pragma unroll
    for (int r = 0; r < 16; ++r) p0[r] = fmaf(p0[r], C, mnC);
#pragma unroll
    for (int r = 0; r < 16; ++r) p1[r] = fmaf(p1[r], C, mnC);
#pragma unroll
    for (int r = 0; r < 16; ++r) p0[r] = __builtin_amdgcn_exp2f(p0[r]);
}
__device__ __forceinline__ void at_finishSM(f32x16& p0, f32x16& p1, float alpha, float& l_reg, bf16x8& pa0, bf16x8& pa1, bf16x8& pa2, bf16x8& pa3) {
#pragma unroll
    for (int r = 0; r < 16; ++r) p1[r] = __builtin_amdgcn_exp2f(p1[r]);
    float ps = 0;
#pragma unroll
    for (int r = 0; r < 16; ++r) ps += p0[r];
#pragma unroll
    for (int r = 0; r < 16; ++r) ps += p1[r];
    { auto rr = __builtin_amdgcn_permlane32_swap(__float_as_uint(ps), __float_as_uint(ps), false, false);
      ps = __uint_as_float(rr[0]) + __uint_as_float(rr[1]); }
    l_reg = l_reg * alpha + ps;
#define PK4(P, BASE, OUT) do { unsigned a0 = cvt_pk_bf16(P[BASE + 0], P[BASE + 1]), a1 = cvt_pk_bf16(P[BASE + 2], P[BASE + 3]);   \
    unsigned b0 = cvt_pk_bf16(P[BASE + 4], P[BASE + 5]), b1 = cvt_pk_bf16(P[BASE + 6], P[BASE + 7]);                              \
    auto r0 = __builtin_amdgcn_permlane32_swap(a0, b0, false, false); auto r1 = __builtin_amdgcn_permlane32_swap(a1, b1, false, false); \
    u32x4 w = {r0[0], r1[0], r0[1], r1[1]}; OUT = *reinterpret_cast<bf16x8*>(&w); } while (0)
    PK4(p0, 0, pa0); PK4(p0, 8, pa1); PK4(p1, 0, pa2); PK4(p1, 8, pa3);
#undef PK4
}
__device__ __forceinline__ void at_qkt(f32x16& p0, f32x16& p1, const char* Ks, const bf16x8* qr, int r32, int hi) {
    p0 = f32x16{}; p1 = f32x16{};
#pragma unroll
    for (int d0 = 0; d0 < 4; ++d0) { const int cb = (d0 * 16 + hi * 8) * 2;
        bf16x8 b0 = *reinterpret_cast<const bf16x8*>(Ks + KSWZ64(r32, cb));
        bf16x8 b1 = *reinterpret_cast<const bf16x8*>(Ks + KSWZ64(32 + r32, cb));
        p0 = __builtin_amdgcn_mfma_f32_32x32x16_bf16(b0, qr[d0], p0, 0, 0, 0);
        p1 = __builtin_amdgcn_mfma_f32_32x32x16_bf16(b1, qr[d0], p1, 0, 0, 0); }
}
__device__ __forceinline__ int v_st(int k, int c) { const int kk = (k & ~0xC) | ((k & 4) << 1) | ((k & 8) >> 1); return ((kk >> 3) * 4 + (c >> 5)) * 512 + ((kk & 7) * 32 + (c & 31)) * 2; }
__device__ __forceinline__ int v_rd_base(int lane) { return ((lane & 3) << 3) | (((lane >> 2) & 3) << 6) | (((lane >> 4) & 1) << 5) | (((lane >> 5) & 1) << 8); }
constexpr int v_rd_off(int d0, int ks, int half) { return d0 * 512 + ks * 4096 + half * 2048; }
template <int OFF> __device__ __forceinline__ s16x4 tr_read(int vb) {
    s16x4 r; asm volatile("ds_read_b64_tr_b16 %0, %1 offset:%2" : "=&v"(r) : "v"(vb), "i"(OFF) : "memory"); return r;
}
template <int D0> __device__ __forceinline__ void pv_one(f32x16& od, int vb, bf16x8 pa0, bf16x8 pa1, bf16x8 pa2, bf16x8 pa3) {
    const s16x4 l0 = tr_read<v_rd_off(D0, 0, 0)>(vb), h0 = tr_read<v_rd_off(D0, 0, 1)>(vb), l1 = tr_read<v_rd_off(D0, 1, 0)>(vb), h1 = tr_read<v_rd_off(D0, 1, 1)>(vb);
    const s16x4 l2 = tr_read<v_rd_off(D0, 2, 0)>(vb), h2 = tr_read<v_rd_off(D0, 2, 1)>(vb), l3 = tr_read<v_rd_off(D0, 3, 0)>(vb), h3 = tr_read<v_rd_off(D0, 3, 1)>(vb);
    asm volatile("s_waitcnt lgkmcnt(0)" ::: "memory"); SBAR();
#define PK(L, H) (bf16x8){L[0], L[1], L[2], L[3], H[0], H[1], H[2], H[3]}
    od = __builtin_amdgcn_mfma_f32_32x32x16_bf16(pa0, PK(l0, h0), od, 0, 0, 0);
    od = __builtin_amdgcn_mfma_f32_32x32x16_bf16(pa1, PK(l1, h1), od, 0, 0, 0);
    od = __builtin_amdgcn_mfma_f32_32x32x16_bf16(pa2, PK(l2, h2), od, 0, 0, 0);
    od = __builtin_amdgcn_mfma_f32_32x32x16_bf16(pa3, PK(l3, h3), od, 0, 0, 0);
#undef PK
}
__device__ __forceinline__ void pv_d0(f32x16* o, int vb, bf16x8 pa0, bf16x8 pa1, bf16x8 pa2, bf16x8 pa3) {
    pv_one<0>(o[0], vb, pa0, pa1, pa2, pa3); pv_one<1>(o[1], vb, pa0, pa1, pa2, pa3); pv_one<2>(o[2], vb, pa0, pa1, pa2, pa3); pv_one<3>(o[3], vb, pa0, pa1, pa2, pa3);
}
__device__ __forceinline__ float psm_max(const f32x16& p0, const f32x16& p1) {
    float pmax = p0[0];
#pragma unroll
    for (int r = 1; r < 16; ++r) pmax = fmaxf(pmax, p0[r]);
#pragma unroll
    for (int r = 0; r < 16; ++r) pmax = fmaxf(pmax, p1[r]);
    auto rr = __builtin_amdgcn_permlane32_swap(__float_as_uint(pmax), __float_as_uint(pmax), false, false);
    return fmaxf(__uint_as_float(rr[0]), __uint_as_float(rr[1]));
}
__device__ __forceinline__ void psm_decide(float pmax, float& m_reg, float& mn, float& alpha) {
    constexpr float C = AT_SCALE * 1.4426950408889634f;
    if (__builtin_expect(__all(pmax - m_reg <= AT_THR / AT_SCALE), 1)) { mn = m_reg; alpha = 1.f; }
    else { mn = fmaxf(m_reg, pmax); alpha = __builtin_amdgcn_exp2f((m_reg - mn) * C); m_reg = mn; }
}
__device__ __forceinline__ void psm_fma(f32x16& p0, f32x16& p1, float mn) {
    constexpr float C = AT_SCALE * 1.4426950408889634f;
    const float mnC = -mn * C;
#pragma unroll
    for (int r = 0; r < 16; ++r) p0[r] = fmaf(p0[r], C, mnC);
#pragma unroll
    for (int r = 0; r < 16; ++r) p1[r] = fmaf(p1[r], C, mnC);
}
__device__ __forceinline__ void psm_exp(f32x16& p0) {
#pragma unroll
    for (int r = 0; r < 16; ++r) p0[r] = __builtin_amdgcn_exp2f(p0[r]);
}
__device__ __forceinline__ void fin_sum(f32x16& p0, f32x16& p1, float alpha, float& l_reg) {
#pragma unroll
    for (int r = 0; r < 16; ++r) p1[r] = __builtin_amdgcn_exp2f(p1[r]);
    float ps = 0;
#pragma unroll
    for (int r = 0; r < 16; ++r) ps += p0[r];
#pragma unroll
    for (int r = 0; r < 16; ++r) ps += p1[r];
    auto rr = __builtin_amdgcn_permlane32_swap(__float_as_uint(ps), __float_as_uint(ps), false, false);
    ps = __uint_as_float(rr[0]) + __uint_as_float(rr[1]);
    l_reg = l_reg * alpha + ps;
}
template <int BASE> __device__ __forceinline__ bf16x8 pk4(const f32x16& P) {
    unsigned a0 = cvt_pk_bf16(P[BASE + 0], P[BASE + 1]), a1 = cvt_pk_bf16(P[BASE + 2], P[BASE + 3]);
    unsigned b0 = cvt_pk_bf16(P[BASE + 4], P[BASE + 5]), b1 = cvt_pk_bf16(P[BASE + 6], P[BASE + 7]);
    auto r0 = __builtin_amdgcn_permlane32_swap(a0, b0, false, false); auto r1 = __builtin_amdgcn_permlane32_swap(a1, b1, false, false);
    u32x4 w = {r0[0], r1[0], r0[1], r1[1]}; return *reinterpret_cast<bf16x8*>(&w);
}
template <int KS> __device__ __forceinline__ void pv_k(f32x16* o, int vb, bf16x8 pa) {
    const s16x4 l0 = tr_read<v_rd_off(0, KS, 0)>(vb), h0 = tr_read<v_rd_off(0, KS, 1)>(vb), l1 = tr_read<v_rd_off(1, KS, 0)>(vb), h1 = tr_read<v_rd_off(1, KS, 1)>(vb);
    const s16x4 l2 = tr_read<v_rd_off(2, KS, 0)>(vb), h2 = tr_read<v_rd_off(2, KS, 1)>(vb), l3 = tr_read<v_rd_off(3, KS, 0)>(vb), h3 = tr_read<v_rd_off(3, KS, 1)>(vb);
    asm volatile("s_waitcnt lgkmcnt(0)" ::: "memory"); SBAR();
#define PK(L, H) (bf16x8){L[0], L[1], L[2], L[3], H[0], H[1], H[2], H[3]}
    o[0] = __builtin_amdgcn_mfma_f32_32x32x16_bf16(pa, PK(l0, h0), o[0], 0, 0, 0);
    o[1] = __builtin_amdgcn_mfma_f32_32x32x16_bf16(pa, PK(l1, h1), o[1], 0, 0, 0);
    o[2] = __builtin_amdgcn_mfma_f32_32x32x16_bf16(pa, PK(l2, h2), o[2], 0, 0, 0);
    o[3] = __builtin_amdgcn_mfma_f32_32x32x16_bf16(pa, PK(l3, h3), o[3], 0, 0, 0);
#undef PK
}
#define AT_STEP(pC0, pC1, alC, pN0, pN1, mnN, alN, KB, VB, LOADSTMT) do { \
    SBAR(); at_qkt(pN0, pN1, KB, qr, r32, hi); fin_sum(pC0, pC1, alC, l_reg); pa0 = pk4<0>(pC0); pa1 = pk4<8>(pC0); SBAR(); \
    LOADSTMT; SBAR(); \
    pv_k<0>(o, VB, pa0); pa2 = pk4<0>(pC1); pa3 = pk4<8>(pC1); \
    pv_k<1>(o, VB, pa1); { const float pm_ = psm_max(pN0, pN1); \
    pv_k<2>(o, VB, pa2); psm_decide(pm_, m_reg, mnN, alN); } psm_fma(pN0, pN1, mnN); \
    pv_k<3>(o, VB, pa3); psm_exp(pN0); asm volatile("" : "+v"(pN0), "+v"(pN1)); SBAR(); } while (0)

template <int COMP>
__device__ __forceinline__ void attn_item(const bf16_t* __restrict__ Qb, const bf16_t* __restrict__ Kh, const bf16_t* __restrict__ Vh, const int seq, char* lds,
                                          const float lam, float* __restrict__ stash, bf16_t* __restrict__ outp, const float* __restrict__ gsub) {
    const int tid = opaque_tid(), wid = tid >> 6, lane = tid & 63, r32 = lane & 31, hi = lane >> 5;
    char* V_lds = lds; char* K_lds = lds + 3 * SHM_V;
    float* ws = (float*)(lds + 3 * SHM_V + 3 * SHM_K) + wid * 64; float* li_l = ws; float* al_l = ws + 32;
    float m_reg = -1e30f, l_reg = 0; f32x16 o[4] = {}; bf16x8 qr[4];
    const bf16_t* Qw = Qb + (long)(wid * 32 + r32) * AT_LD + hi * 8;
#pragma unroll
    for (int d0 = 0; d0 < 4; ++d0) qr[d0] = *reinterpret_cast<const bf16x8*>(Qw + d0 * 16);
    const int vb0 = (int)(uintptr_t)V_lds + v_rd_base(lane);
    const int widu = __builtin_amdgcn_readfirstlane(wid);
    LAS unsigned char* ldsl = (LAS unsigned char*)lds;
    unsigned koff, voff0, voff1;
    { const int row = widu * 8 + (lane >> 3), chunk = (lane & 7) ^ ((row >> 1) & 7); koff = (unsigned)(row * AT_LDK + chunk * 8); }
    { const int b = widu * 1024 + lane * 16, st_ = b >> 9, e = (b & 511) >> 1, kk = (st_ >> 2) * 8 + (e >> 5), c = (st_ & 3) * 32 + (e & 31), k = (kk & ~0xC) | ((kk & 4) << 1) | ((kk & 8) >> 1); voff0 = (unsigned)(k * AT_LDV + c); }
    { const int b = 8192 + widu * 1024 + lane * 16, st_ = b >> 9, e = (b & 511) >> 1, kk = (st_ >> 2) * 8 + (e >> 5), c = (st_ & 3) * 32 + (e & 31), k = (kk & ~0xC) | ((kk & 4) << 1) | ((kk & 8) >> 1); voff1 = (unsigned)(k * AT_LDV + c); }
#define ADMA(b, k0) do { \
    __builtin_amdgcn_global_load_lds((const unsigned*)(Kh + ((unsigned)((k0) * AT_LDK) + koff)), (LAS unsigned*)(ldsl + 3 * SHM_V + (b) * SHM_K + widu * 1024), 16, 0, 0); \
    __builtin_amdgcn_global_load_lds((const unsigned*)(Vh + ((unsigned)((k0) * AT_LDV) + voff0)), (LAS unsigned*)(ldsl + (b) * SHM_V + widu * 1024), 16, 0, 0); \
    __builtin_amdgcn_global_load_lds((const unsigned*)(Vh + ((unsigned)((k0) * AT_LDV) + voff1)), (LAS unsigned*)(ldsl + (b) * SHM_V + 8192 + widu * 1024), 16, 0, 0); } while (0)
#define SWAIT() asm volatile("s_waitcnt vmcnt(0)" ::: "memory")
#define RESC(a) do { if (__any((a) < 1.f)) { if (hi == 0) al_l[r32] = (a); asm volatile("s_waitcnt lgkmcnt(0)" ::: "memory"); \
    _Pragma("unroll") for (int d = 0; d < 4; ++d) _Pragma("unroll") for (int r = 0; r < 16; ++r) o[d][r] *= al_l[crow(r, hi)]; } } while (0)
    f32x16 pA0, pA1, pB0, pB1; float mnA, mnB, alA, alB; bf16x8 pa0, pa1, pa2, pa3; const int NT = seq / 64;
    __syncthreads();
    ADMA(0, 0); ADMA(1, 64); SWAIT(); __syncthreads();
    at_qkt(pA0, pA1, K_lds, qr, r32, hi); at_partialSM(pA0, pA1, m_reg, mnA, alA);
    int ib0 = 0, ib1 = 1, ib2 = 2;
#define AT_FULL(pC0, pC1, alC, pN0, pN1, mnN, alN, J) do { \
    if ((J) + 1 < NT) ADMA(ib2, ((J) + 1) * 64); \
    AT_STEP(pC0, pC1, alC, pN0, pN1, mnN, alN, K_lds + ib1 * SHM_K, vb0 + ib0 * SHM_V, (void)0); \
    RESC(alN); SWAIT(); __syncthreads(); { const int t_ = ib0; ib0 = ib1; ib1 = ib2; ib2 = t_; } } while (0)
    for (int j = 1; j + 1 < NT; j += 2) {
        AT_FULL(pA0, pA1, alA, pB0, pB1, mnB, alB, j);
        AT_FULL(pB0, pB1, alB, pA0, pA1, mnA, alA, j + 1);
    }
    AT_FULL(pA0, pA1, alA, pB0, pB1, mnB, alB, NT - 1);
    at_finishSM(pB0, pB1, alB, l_reg, pa0, pa1, pa2, pa3); SBAR();
    pv_d0(o, vb0 + ib0 * SHM_V, pa0, pa1, pa2, pa3);
    if (hi == 0) li_l[r32] = l_reg; asm volatile("s_waitcnt lgkmcnt(0)" ::: "memory");
    unsigned* Sw = (unsigned*)(lds + 75776) + wid * 2048 + lane;
    (void)stash;
    if (COMP == 0) {
#pragma unroll
        for (int r = 0; r < 16; ++r) { const float rl = __builtin_amdgcn_rcpf(li_l[crow(r, hi)]);
            Sw[(r * 2 + 0) * 64] = cvt_pk_bf16(o[0][r] * rl, o[1][r] * rl); Sw[(r * 2 + 1) * 64] = cvt_pk_bf16(o[2][r] * rl, o[3][r] * rl); }
    } else {
        bf16_t* Ow = outp + (unsigned)(wid * 32 + 4 * hi) * DM + r32;
        float g4[4];
#pragma unroll
        for (int d0 = 0; d0 < 4; ++d0) g4[d0] = gsub[d0 * 32 + r32] * 0.8f;
#pragma unroll
        for (int r = 0; r < 16; ++r) { const float rl = __builtin_amdgcn_rcpf(li_l[crow(r, hi)]) * lam;
            float v[4]; float ss = 0.f;
            { const unsigned u0 = Sw[(r * 2 + 0) * 64], u1 = Sw[(r * 2 + 1) * 64];
              v[0] = __uint_as_float(u0 << 16) - o[0][r] * rl; v[1] = __uint_as_float(u0 & 0xffff0000u) - o[1][r] * rl;
              v[2] = __uint_as_float(u1 << 16) - o[2][r] * rl; v[3] = __uint_as_float(u1 & 0xffff0000u) - o[3][r] * rl; }
#pragma unroll
            for (int d0 = 0; d0 < 4; ++d0) ss += v[d0] * v[d0];
#pragma unroll
            for (int sh = 1; sh < 32; sh <<= 1) ss += __shfl_xor(ss, sh);
            const float rs = rsqrtf(ss * (1.f / 128.f) + 1e-5f);
#pragma unroll
            for (int d0 = 0; d0 < 4; ++d0) Ow[(unsigned)(((r & 3) + 8 * (r >> 2)) * DM + d0 * 32)] = f2bf(v[d0] * rs * g4[d0]);
            __builtin_amdgcn_sched_barrier(0); }
    }
#undef ADMA
#undef SWAIT
#undef RESC
#undef AT_FULL
}

__device__ __forceinline__ void attn_phase(const Params& p, char* lds) {
    const int lane = opaque_tid() & 63;
    const float s1 = wave_sum(p.lq1[lane] * p.lk1[lane]), s2 = wave_sum(p.lq2[lane] * p.lk2[lane]);
    const float lam = __expf(s1) - __expf(s2) + 0.2f;
    const bf16_t* PROJ = (const bf16_t*)(p.ws + WS_A);
    bf16_t* MIX = (bf16_t*)(p.ws + WS_C);
    for (int it = blockIdx.x; it < 1280; it += gridDim.x) {
        int gb, h, qb, seq;
        if (it < 1024) { const int rr = it >> 8, c = it & 255, bh = rr * 8 + (c & 7); gb = bh >> 3; h = bh & 7; qb = c >> 3; seq = 8192; }
        else { const int c = it - 1024, bh = (c & 7) * 2 + (c >> 7); gb = 4 + (bh >> 3); h = bh & 7; qb = (c >> 3) & 15; seq = 4096; }
        const int t0 = tok0_of(gb);
        const size_t row0 = (size_t)t0 + (size_t)qb * 256;
        float* stash = p.out + (size_t)it * 32768;
        bf16_t* outp = MIX + row0 * DM + 1024 + h * 128;
        const bf16_t* KHp = (const bf16_t*)p.out + 83886080; const bf16_t* VHp = KHp + 41943040;
        const bf16_t* Kb = KHp + (size_t)t0 * 1024 + (size_t)(h * 2) * seq * 64; const bf16_t* Vb = VHp + (size_t)t0 * 1024 + (size_t)h * seq * 128; const bf16_t* Qb = PROJ + row0 * NPROJ + 1024 + h * 128;
        attn_item<0>(Qb, Kb, Vb, seq, lds, lam, stash, outp, p.g_subln);
        attn_item<1>(Qb + 64, Kb + (size_t)seq * 64, Vb, seq, lds, lam, stash, outp, p.g_subln);
    }
}

__device__ __forceinline__ bf16x8 gatherB(const LAS bf16_t* Ds, int pitch, int kbase, int n) {
    bf16x8 b;
#pragma unroll
    for (int j = 0; j < 8; ++j) b[j] = (short)Ds[(kbase + j) * pitch + n];
    return b;
}
__device__ __forceinline__ void fftA_phase(const Params& p, LAS unsigned char* lds) {
    const int tid = opaque_tid(), wid = tid >> 6, lane = tid & 63, r32 = lane & 31, hi = lane >> 5;
    constexpr int PM = 136, PD = 136, PU = 136;
    LAS bf16_t* Ms = (LAS bf16_t*)lds; LAS bf16_t* Ds = (LAS bf16_t*)(lds + 128 * PM * 2); LAS bf16_t* Us = (LAS bf16_t*)(lds + 128 * PM * 2 + 128 * PD * 2);
    const bf16_t* PROJ = (const bf16_t*)(p.ws + WS_A); bf16_t* Y = (bf16_t*)(p.ws + WS_B); const bf16_t* FM = (const bf16_t*)(p.ws + WS_FMA); const bf16_t* FCT = (const bf16_t*)(p.ws + WS_FCT);
    __syncthreads();
#pragma unroll
    for (int i = 0; i < 4; ++i) { const int q = tid + 512 * i, row = q >> 4, c8 = (q & 15) * 8; *(LAS u32x4*)(Ms + row * PM + c8) = *(const u32x4*)(FM + row * 128 + c8); }
    bf16x8 fc[8];
#pragma unroll
    for (int ks = 0; ks < 8; ++ks) fc[ks] = *(const bf16x8*)(FCT + (wid * 32 + r32) * 128 + ks * 16 + hi * 8);
    u32x4 st[2];
    auto decode = [&](int u, int& t0, int& s2, int& c0, int& N2, int& S) {
        if (u < 4096) { t0 = (u >> 10) * 8192; const int rem = u & 1023; s2 = rem >> 3; c0 = (rem & 7) * 128; N2 = 128; S = 8192; }
        else { const int v = u - 4096; t0 = 32768 + (v >> 9) * 4096; const int rem = v & 511; s2 = rem >> 3; c0 = (rem & 7) * 128; N2 = 64; S = 4096; } };
    auto loadu = [&](int u) { int t0, s2, c0, N2, S; decode(u, t0, s2, c0, N2, S);
#pragma unroll
        for (int i = 0; i < 2; ++i) { const int q = tid + 512 * i, s1 = q >> 4, c8 = (q & 15) * 8;
            st[i] = *(const u32x4*)(PROJ + (size_t)(t0 + s1 * N2 + s2) * NPROJ + c0 + c8); } };
    int u = blockIdx.x;
    if (u < 5120) loadu(u);
    for (; u < 5120; u += gridDim.x) {
        __syncthreads();
#pragma unroll
        for (int i = 0; i < 2; ++i) { const int q = tid + 512 * i, s1 = q >> 4, c8 = (q & 15) * 8; *(LAS u32x4*)(Us + s1 * PU + c8) = st[i]; }
        __syncthreads();
        if (u + (int)gridDim.x < 5120) loadu(u + gridDim.x);
        {
            f32x16 c0a = {}, c1a = {};
#pragma unroll
            for (int ks = 0; ks < 8; ++ks) { const int kb = ks * 16 + hi * 8;
                const bf16x8 u0 = *(const LAS bf16x8*)(Us + r32 * PU + kb), u1 = *(const LAS bf16x8*)(Us + (32 + r32) * PU + kb);
                c0a = __builtin_amdgcn_mfma_f32_32x32x16_bf16(u0, fc[ks], c0a, 0, 0, 0); c1a = __builtin_amdgcn_mfma_f32_32x32x16_bf16(u1, fc[ks], c1a, 0, 0, 0); }
            const int n = wid * 32 + r32, pp = n >> 7, cp = n & 127;
#pragma unroll
            for (int r = 0; r < 16; ++r) { const int s1 = crow(r, hi);
                Ds[(pp * 64 + s1) * PD + cp] = f2bf_rne(c0a[r]); Ds[(pp * 64 + 32 + s1) * PD + cp] = f2bf_rne(c1a[r]); }
        }
        __syncthreads();
        int t0, s2, c0, N2, S; decode(u, t0, s2, c0, N2, S);
        const int nb = wid & 3, mp = wid >> 2;
        f32x16 a0 = {}, a1 = {};
#pragma unroll
        for (int ks = 0; ks < 8; ++ks) { const int kb = ks * 16 + hi * 8;
            const bf16x8 b = gatherB(Ds, PD, kb, nb * 32 + r32);
            const bf16x8 m0 = *(const LAS bf16x8*)(Ms + (mp * 32 + r32) * PM + kb), m1 = *(const LAS bf16x8*)(Ms + (64 + mp * 32 + r32) * PM + kb);
            a0 = __builtin_amdgcn_mfma_f32_32x32x16_bf16(m0, b, a0, 0, 0, 0); a1 = __builtin_amdgcn_mfma_f32_32x32x16_bf16(m1, b, a1, 0, 0, 0); }
        const float invS = 1.f / (float)S;
#pragma unroll
        for (int r = 0; r < 16; ++r) { const int k1 = mp * 32 + crow(r, hi); const int j = (s2 * k1) & (S - 1); const float fr = (float)j * invS;
            const float cs = __builtin_amdgcn_cosf(fr), sn = __builtin_amdgcn_sinf(fr);
            const float yr = a0[r], yi = a1[r], orr = yr * cs + yi * sn, oi = yi * cs - yr * sn;
            bf16_t* d = Y + (size_t)(t0 + k1 * N2 + s2) * DM + c0 + nb * 32 + r32;
            d[0] = f2bf(orr); d[1024] = f2bf(oi); }
    }
}
template <int N2>
__device__ __forceinline__ void fftC_phase(const Params& p, LAS unsigned char* lds) {
    const int tid = opaque_tid(), wid = tid >> 6, lane = tid & 63, r32 = lane & 31, hi = lane >> 5;
    constexpr int KD = 2 * N2, PM = KD + 8, PD = 72, S = 64 * N2, NPC = KD * 8 / 512  , NU = (N2 == 128 ? 4096 : 2048);
    LAS bf16_t* Ms = (LAS bf16_t*)lds; LAS bf16_t* Ds = (LAS bf16_t*)(lds + 128 * 264 * 2);
    const bf16_t* Y = (const bf16_t*)(p.ws + WS_B); bf16_t* MIX = (bf16_t*)(p.ws + WS_C); const bf16_t* FM = (const bf16_t*)(p.ws + (N2 == 128 ? WS_FMC128 : WS_FMC64));
    const float scale = N2 == 128 ? 9.765625e-4f   : 1.3810679320049757e-3f  ;
    __syncthreads();
    for (int q = tid; q < N2 * KD / 8; q += 512) { const int row = q / (KD / 8), c8 = (q % (KD / 8)) * 8; *(LAS u32x4*)(Ms + row * PM + c8) = *(const u32x4*)(FM + row * KD + c8); }
    u32x4 st[NPC];
    auto decode = [&](int u, int& t0, int& k1, int& c0) { const int gbl = u >> 10; t0 = (N2 == 128 ? gbl * 8192 : 32768 + gbl * 4096); k1 = (u >> 4) & 63; c0 = (u & 15) * 64; };
    auto loadu = [&](int u) { int t0, k1, c0; decode(u, t0, k1, c0);
#pragma unroll
        for (int i = 0; i < NPC; ++i) { const int q = tid + 512 * i, row = q >> 3, c8 = (q & 7) * 8, pp = row / N2, s2 = row % N2;
            st[i] = *(const u32x4*)(Y + (size_t)(t0 + k1 * N2 + s2) * DM + pp * 1024 + c0 + c8); } };
    int u = blockIdx.x;
    if (u < NU) loadu(u);
    for (; u < NU; u += gridDim.x) {
        __syncthreads();
#pragma unroll
        for (int i = 0; i < NPC; ++i) { const int q = tid + 512 * i, row = q >> 3, c8 = (q & 7) * 8; *(LAS u32x4*)(Ds + row * PD + c8) = st[i]; }
        __syncthreads();
        if (u + (int)gridDim.x < NU) loadu(u + gridDim.x);
        int t0, k1, c0; decode(u, t0, k1, c0);
        constexpr int NMB = N2 / 32;
        const int mb = wid % NMB, nb = wid / NMB;
        if (nb < 2) {
            f32x16 a0 = {};
#pragma unroll
            for (int ks = 0; ks < KD / 16; ++ks) { const int kb = ks * 16 + hi * 8;
                const bf16x8 b = gatherB(Ds, PD, kb, nb * 32 + r32);
                const bf16x8 m0 = *(const LAS bf16x8*)(Ms + (mb * 32 + r32) * PM + kb);
                a0 = __builtin_amdgcn_mfma_f32_32x32x16_bf16(m0, b, a0, 0, 0, 0); }
#pragma unroll
            for (int r = 0; r < 16; ++r) { const int k2 = mb * 32 + crow(r, hi);
                MIX[(size_t)(t0 + k1 + 64 * k2) * DM + c0 + nb * 32 + r32] = f2bf(a0[r] * scale); }
        }
    }
}

__device__ __forceinline__ void p0_tr_item(const float* __restrict__ W, int ldw, int k0, int n0, bf16_t* __restrict__ WT, int ldt, int kd0, int drow0, bool qkperm,
                                           const float* __restrict__ ksc, LAS float* scr, int lane) {
    const int lr = lane >> 4, lq = (lane & 15) * 4;
    f32x4 v[16];
#pragma unroll
    for (int i = 0; i < 16; ++i) v[i] = *(const f32x4*)(W + (size_t)(k0 + 4 * i + lr) * ldw + n0 + lq);
#pragma unroll
    for (int i = 0; i < 16; ++i) { const int kk = 4 * i + lr; f32x4 x = v[i]; if (ksc) x = x * ksc[k0 + kk];
        LAS float* d = scr + kk * 65 + lq; d[0] = x[0]; d[1] = x[1]; d[2] = x[2]; d[3] = x[3]; }
    asm volatile("s_waitcnt lgkmcnt(0)" ::: "memory");
    const int c = lane & 7;
#pragma unroll
    for (int j = 0; j < 8; ++j) { const int n = (lane >> 3) + 8 * j; const LAS float* sp = scr + (8 * c) * 65 + n;
        u32x4 o = {cvt_pk_bf16(sp[0 * 65], sp[1 * 65]), cvt_pk_bf16(sp[2 * 65], sp[3 * 65]), cvt_pk_bf16(sp[4 * 65], sp[5 * 65]), cvt_pk_bf16(sp[6 * 65], sp[7 * 65])};
        const int dr = drow0 + (qkperm ? 2 * (n & 31) + (n >> 5) : n);
        *(u32x4*)(WT + (size_t)dr * ldt + kd0 + 8 * c) = o; }
    asm volatile("s_waitcnt lgkmcnt(0)" ::: "memory");
}
__device__ __forceinline__ void norm_row_bf16(const float* __restrict__ xrow, const float* __restrict__ g, bf16_t* __restrict__ orow, int lane) {
    const f32x4* xr = (const f32x4*)xrow + lane; const f32x4* gr = (const f32x4*)g + lane;
    f32x4 v[8]; float s = 0.f;
#pragma unroll
    for (int j = 0; j < 8; ++j) { v[j] = xr[64 * j]; s += (v[j][0] * v[j][0] + v[j][1] * v[j][1]) + (v[j][2] * v[j][2] + v[j][3] * v[j][3]); }
    const float rs = rsqrtf(wave_sum(s) * (1.f / DM) + EPS);
#pragma unroll
    for (int j = 0; j < 8; ++j) { const f32x4 gg = gr[64 * j]; u32x2 w = {cvt_pk_bf16(v[j][0] * rs * gg[0], v[j][1] * rs * gg[1]), cvt_pk_bf16(v[j][2] * rs * gg[2], v[j][3] * rs * gg[3])};
        *((u32x2*)orow + lane + 64 * j) = w; }
}
__device__ __forceinline__ void p0_prologue(const Params& p, LAS unsigned char* lds) {
    const int tid = opaque_tid(), wid = tid >> 6, lane = tid & 63, G = gridDim.x;
    bf16_t* WIN = (bf16_t*)(p.ws + WS_WIN); bf16_t* WOUT = (bf16_t*)(p.ws + WS_WOUT);
    for (int it = blockIdx.x; it < 256; it += G) {
        const int g = it & 7, n0 = (it >> 3) * 64;
        LAS float* Fs = (LAS float*)lds; LAS float* Bs = Fs + 128 * 129;
        __syncthreads();
        for (int q = tid; q < 128 * 128; q += 512) { const int cp = q >> 7, d = q & 127; Fs[cp * 129 + d] = p.w_f[(size_t)g * 16384 + q]; }
        for (int q = tid; q < 128 * 64; q += 512) { const int d = q >> 6, n = q & 63; Bs[d * 65 + n] = p.w_out[(size_t)(g * 128 + d) * DM + n0 + n]; }
        __syncthreads();
        const int n = tid & 63, cgp = tid >> 6;
        float acc[16];
#pragma unroll
        for (int j = 0; j < 16; ++j) acc[j] = 0.f;
        for (int d = 0; d < 128; ++d) { const float b = Bs[d * 65 + n];
#pragma unroll
            for (int j = 0; j < 16; ++j) acc[j] += Fs[(cgp * 16 + j) * 129 + d] * b; }
        u32x4 w0 = {cvt_pk_bf16(acc[0], acc[1]), cvt_pk_bf16(acc[2], acc[3]), cvt_pk_bf16(acc[4], acc[5]), cvt_pk_bf16(acc[6], acc[7])};
        u32x4 w1 = {cvt_pk_bf16(acc[8], acc[9]), cvt_pk_bf16(acc[10], acc[11]), cvt_pk_bf16(acc[12], acc[13]), cvt_pk_bf16(acc[14], acc[15])};
        bf16_t* d = WOUT + (size_t)(n0 + n) * DM + g * 128 + cgp * 16;
        *(u32x4*)d = w0; *(u32x4*)(d + 8) = w1;
    }
    __syncthreads();
    {
        LAS float* scr = (LAS float*)lds + wid * (64 * 65);
        const int gw = blockIdx.x * 8 + wid, GW = G * 8;
        for (int it = gw; it < 14080; it += GW) {
            int r = it;
            if (r < 2048) { const int kb = r >> 6, nb = r & 63, n = nb * 64;
                p0_tr_item(p.w_in, 4096, kb * 64, n, WIN, DM, kb * 64, n, n >= 1024 && n < 3072, nullptr, scr, lane); continue; } r -= 2048;
            if (r < 512) { const int kb = r >> 5, nb = r & 31; p0_tr_item(p.w_out, DM, 1024 + kb * 64, nb * 64, WOUT, DM, 1024 + kb * 64, nb * 64, false, nullptr, scr, lane); continue; } r -= 512;
            if (r < 3072) { const int w = r >> 10, q = r & 1023, kb = q >> 5, nb = q & 31;
                if (w == 0) p0_tr_item(p.w_ck, DM, kb * 64, nb * 64, (bf16_t*)(p.ws + WS_WCK), DM, kb * 64, nb * 64, false, nullptr, scr, lane);
                else if (w == 1) p0_tr_item(p.w_cv, DM, kb * 64, nb * 64, (bf16_t*)(p.ws + WS_WCV), DM, kb * 64, nb * 64, false, nullptr, scr, lane);
                else p0_tr_item(p.w_co, DM, kb * 64, nb * 64, (bf16_t*)(p.ws + WS_WCO), DM, kb * 64, nb * 64, false, nullptr, scr, lane);
                continue; } r -= 3072;
            if (r < 5632) { const int up = r >= 2816, q = up ? r - 2816 : r, kb = q / 88, nb = q % 88, n0 = nb * 64;
                p0_tr_item(up ? p.w_up : p.w_gate, DFF, kb * 64, n0, (bf16_t*)(p.ws + WS_WGU), DM, kb * 64, 256 * (n0 >> 7) + (n0 & 127) + (up ? 128 : 0), false, p.g_ffn, scr, lane); continue; } r -= 5632;
            { const int kb = r >> 5, nb = r & 31; p0_tr_item(p.w_down, DM, kb * 64, nb * 64, (bf16_t*)(p.ws + WS_WD), DFF, kb * 64, nb * 64, false, nullptr, scr, lane); }
        }
        bf16_t* HA = (bf16_t*)(p.ws + WS_B); bf16_t* MEMN = (bf16_t*)(p.ws + WS_MEMN);
        {
            auto src = [&](int row) -> const float* { if (row < T_ALL) return row < T_P ? p.x_p + (size_t)row * DM : p.x_s + (size_t)(row - T_P) * DM;
                                                     const int mr = row - T_ALL; return mr < 1024 ? p.mem_p + (size_t)mr * DM : p.mem_s + (size_t)(mr - 1024) * DM; };
            f32x4 cur[8], nxt[8];
            int row = gw;
            if (row < T_ALL + NMEMROWS) { const f32x4* xr = (const f32x4*)src(row) + lane;
#pragma unroll
                for (int j = 0; j < 8; ++j) cur[j] = xr[64 * j]; }
            for (; row < T_ALL + NMEMROWS; row += GW) {
                const int nrow = row + GW;
                if (nrow < T_ALL + NMEMROWS) { const f32x4* xr = (const f32x4*)src(nrow) + lane;
#pragma unroll
                    for (int j = 0; j < 8; ++j) nxt[j] = xr[64 * j]; }
                float sq = 0.f;
#pragma unroll
                for (int j = 0; j < 8; ++j) sq += (cur[j][0] * cur[j][0] + cur[j][1] * cur[j][1]) + (cur[j][2] * cur[j][2] + cur[j][3] * cur[j][3]);
                const float rs = rsqrtf(wave_sum(sq) * (1.f / DM) + EPS);
                const f32x4* gr = (const f32x4*)(row < T_ALL ? p.g_mix : p.g_mem) + lane;
                bf16_t* orow = row < T_ALL ? HA + (size_t)row * DM : MEMN + (size_t)(row - T_ALL) * DM;
#pragma unroll
                for (int j = 0; j < 8; ++j) { const f32x4 gg = gr[64 * j]; u32x2 w = {cvt_pk_bf16(cur[j][0] * rs * gg[0], cur[j][1] * rs * gg[1]), cvt_pk_bf16(cur[j][2] * rs * gg[2], cur[j][3] * rs * gg[3])};
                    *((u32x2*)orow + lane + 64 * j) = w; }
#pragma unroll
                for (int j = 0; j < 8; ++j) cur[j] = nxt[j];
            }
        }
    }
    const int gt = blockIdx.x * 512 + tid, GT = G * 512;
    float* sumsq = (float*)(p.ws + WS_SUMSQ);
    for (int i = gt; i < 3 * T_ALL; i += GT) sumsq[i] = 0.f;
    { bf16_t* WQN = (bf16_t*)(p.ws + WS_WCQ);
      for (int i = gt; i < DM * DM / 8; i += GT) { const int k = i >> 8; const float g = p.g_cross[k]; const f32x4 a = *(const f32x4*)(p.w_cq + (size_t)i * 8), b = *(const f32x4*)(p.w_cq + (size_t)i * 8 + 4);
          u32x4 w = {cvt_pk_bf16(a[0] * g, a[1] * g), cvt_pk_bf16(a[2] * g, a[3] * g), cvt_pk_bf16(b[0] * g, b[1] * g), cvt_pk_bf16(b[2] * g, b[3] * g)}; *(u32x4*)(WQN + (size_t)i * 8) = w; } }
    float* rope = (float*)(p.ws + WS_ROPE);
    for (int i = gt; i < 8192 * 32; i += GT) { const int pos = i >> 5, fi = i & 31;
        const double inv = exp2(-(double)fi * 0.41524101186092029), rev = (double)pos * inv * 0.15915494309189535; const float fr = (float)(rev - floor(rev));
        rope[2 * i] = __builtin_amdgcn_cosf(fr); rope[2 * i + 1] = __builtin_amdgcn_sinf(fr); }
    bf16_t* FMA_ = (bf16_t*)(p.ws + WS_FMA); bf16_t* FC128 = (bf16_t*)(p.ws + WS_FMC128); bf16_t* FC64 = (bf16_t*)(p.ws + WS_FMC64);
    for (int i = gt; i < 128 * 128; i += GT) { const int r = i >> 7, c = i & 127, pp = r >> 6, k1 = r & 63, pc = c >> 6, s1 = c & 63; const float fr = (float)((k1 * s1) & 63) * (1.f / 64.f);
        const float cs = __builtin_amdgcn_cosf(fr), sn = __builtin_amdgcn_sinf(fr); FMA_[i] = f2bf(pp == pc ? cs : (pp == 0 ? sn : -sn)); }
    for (int i = gt; i < 128 * 256; i += GT) { const int k2 = i >> 8, c = i & 255, pc = c >> 7, s2 = c & 127; const float fr = (float)((k2 * s2) & 127) * (1.f / 128.f);
        FC128[i] = f2bf(pc == 0 ? __builtin_amdgcn_cosf(fr) : __builtin_amdgcn_sinf(fr)); }
    { bf16_t* FCT = (bf16_t*)(p.ws + WS_FCT);
      for (int i = gt; i < 256 * 128; i += GT) { const int n = i >> 7, c = i & 127, pp = n >> 7, cp = n & 127; const float fr = (float)((c * cp) & 127) * (1.f / 128.f);
          FCT[i] = f2bf(pp == 0 ? __builtin_amdgcn_cosf(fr) : -__builtin_amdgcn_sinf(fr)); } }
    for (int i = gt; i < 64 * 128; i += GT) { const int k2 = i >> 7, c = i & 127, pc = c >> 6, s2 = c & 63; const float fr = (float)((k2 * s2) & 63) * (1.f / 64.f);
        FC64[i] = f2bf(pc == 0 ? __builtin_amdgcn_cosf(fr) : __builtin_amdgcn_sinf(fr)); }
}
__device__ __forceinline__ void final_norm_phase(const Params& p) {
    const int tid = opaque_tid(), wid = tid >> 6, lane = tid & 63;
    const bf16_t* XB = (const bf16_t*)(p.ws + WS_B);
    const f32x4* gr = (const f32x4*)p.g_final;
    const int GW = gridDim.x * 8;
    int row = blockIdx.x * 8 + wid;
    u32x4 cur[4], nxt[4];
    if (row < T_ALL) { const u32x4* xr = (const u32x4*)(XB + (size_t)row * DM) + lane;
#pragma unroll
        for (int j = 0; j < 4; ++j) cur[j] = xr[64 * j]; }
    for (; row < T_ALL; row += GW) {
        const int nrow = row + GW;
        if (nrow < T_ALL) { const u32x4* xr = (const u32x4*)(XB + (size_t)nrow * DM) + lane;
#pragma unroll
            for (int j = 0; j < 4; ++j) nxt[j] = xr[64 * j]; }
        f32x4 v[8]; float s = 0.f;
#pragma unroll
        for (int j = 0; j < 4; ++j) { const u32x4 r = cur[j];
            v[2 * j] = (f32x4){__uint_as_float(r[0] << 16), __uint_as_float(r[0] & 0xffff0000u), __uint_as_float(r[1] << 16), __uint_as_float(r[1] & 0xffff0000u)};
            v[2 * j + 1] = (f32x4){__uint_as_float(r[2] << 16), __uint_as_float(r[2] & 0xffff0000u), __uint_as_float(r[3] << 16), __uint_as_float(r[3] & 0xffff0000u)}; }
#pragma unroll
        for (int j = 0; j < 8; ++j) s += (v[j][0] * v[j][0] + v[j][1] * v[j][1]) + (v[j][2] * v[j][2] + v[j][3] * v[j][3]);
        const float rs = rsqrtf(wave_sum(s) * (1.f / DM) + EPS);
        f32x4* orow = (f32x4*)(p.out + (size_t)row * DM);
#pragma unroll
        for (int j = 0; j < 4; ++j) { const int e4 = (lane + 64 * j) * 2; orow[e4] = v[2 * j] * rs * gr[e4]; orow[e4 + 1] = v[2 * j + 1] * rs * gr[e4 + 1]; }
#pragma unroll
        for (int j = 0; j < 4; ++j) cur[j] = nxt[j];
    }
}

__global__ void __launch_bounds__(512, 2) mega(Params p) {
    extern __shared__ __attribute__((aligned(16))) char shm[];
    LAS unsigned char* lds = (LAS unsigned char*)shm;
    cg::grid_group grid = cg::this_grid();
    unsigned char* ws = p.ws;
    float* sumsq = (float*)(ws + WS_SUMSQ);
#ifdef PROBE_A
#define TSTAMP(i) do { if (blockIdx.x == 0 && threadIdx.x == 0) ((unsigned long long*)(ws + WS_TS))[i] = __builtin_amdgcn_s_memrealtime(); } while (0)
#else
#define TSTAMP(i) do { } while (0)
#endif
#define PHASE(n, ...) if (p.ph_lo <= (n) && (n) < p.ph_hi) { if ((n) > p.ph_lo) grid.sync(); TSTAMP(2 * (n)); if (PHMASK & (1 << (n))) { __VA_ARGS__ } TSTAMP(2 * (n) + 1); }
    PHASE(0, p0_prologue(p, lds);)
    PHASE(1, { P1Sched S; S.ps.init(ws + WS_B, ws + WS_WIN, T_ALL, 4096, DM, DM); S.MEMN = (const char*)(ws + WS_MEMN); S.WCK = (const char*)(ws + WS_WCK); S.WCV = (const char*)(ws + WS_WCV);
               EpiP1 E{EpiProj{(bf16_t*)(ws + WS_A), (const float*)(ws + WS_ROPE), (bf16_t*)p.out + 83886080, (bf16_t*)p.out + 83886080 + 41943040}, EpiStore{(bf16_t*)(ws + WS_KMEM), DM, 0, 256, nullptr}, EpiStore{(bf16_t*)(ws + WS_VMEMT), DM, 0, 256, nullptr}};
               pg8::gemm_phase(lds, DM, DM, DM, S, E); })
    PHASE(2, const bool attn_first = ((blockIdx.x >> 3) & 1) != 0; if (!attn_first) fftA_phase(p, lds); attn_phase(p, shm); if (attn_first) fftA_phase(p, lds);)
    PHASE(3, fftC_phase<128>(p, lds); fftC_phase<64>(p, lds);
             __syncthreads();
             { PrepSched S{(const char*)(ws + WS_KMEM), (const char*)(ws + WS_WCQ), (int)gridDim.x, (int)blockIdx.x}; EpiStore E{(bf16_t*)(ws + WS_A), DM, 0, 256, nullptr}; pg8::gemm_phase(lds, 512, DM, DM, S, E); }
)
    PHASE(4, { pg8::PlainSched S; S.init(ws + WS_C, ws + WS_WOUT, T_ALL, DM, DM, DM); EpiRes<false, false> E{p.x_p, p.x_s, nullptr, nullptr, (bf16_t*)(ws + WS_B), sumsq}; pg8::gemm_phase(lds, DM, DM, DM, S, E); })
    PHASE(6, { ScoreSched S{(const char*)(ws + WS_B), (const char*)(ws + WS_A), (int)gridDim.x, (int)blockIdx.x};
               EpiSoftmax E{(bf16_t*)(ws + WS_A + (size_t)T_ALL * DM * 2), (LAS float*)(lds + 131072), sumsq}; pg8::gemm_phase<true, false>(lds, DM, DM, DM, S, E); }
               { Prep2Sched S{(const char*)(ws + WS_WCO), (const char*)(ws + WS_VMEMT), (int)gridDim.x / 2, (int)blockIdx.x - (int)gridDim.x / 2}; EpiStore E{(bf16_t*)(ws + WS_A + (32u << 20)), 1024, 0, 256, nullptr}; pg8::gemm_phase(lds, 512, DM, DM, S, E); })
    PHASE(8, { OutSched S; S.ps.init(ws + WS_A + (size_t)T_ALL * DM * 2, ws + WS_A, T_ALL, DM, 1024, 1024); S.VWT = (const char*)(ws + WS_A + (32u << 20));
               EpiRes<true, false> E{nullptr, nullptr, (const bf16_t*)(ws + WS_B), nullptr, (bf16_t*)(ws + WS_B), sumsq + T_ALL}; pg8::gemm_phase(lds, 1024, 1024, 1024, S, E); })
    PHASE(9, { pg8::PlainSched S; S.init(ws + WS_B, ws + WS_WGU, T_ALL, 2 * DFF, DM, DM); EpiSwiglu E{(bf16_t*)(ws + WS_A), sumsq + T_ALL}; pg8::gemm_phase(lds, DM, DM, DM, S, E); })
    PHASE(10, { pg8::PlainSched S; S.init(ws + WS_A, ws + WS_WD, T_ALL, DM, DFF, DFF); EpiRes<true, false> E{nullptr, nullptr, (const bf16_t*)(ws + WS_B), nullptr, (bf16_t*)(ws + WS_B), nullptr}; pg8::gemm_phase(lds, DFF, DFF, DFF, S, E); })
#ifdef PROBE_A
    PHASE(11, final_norm_phase(p);)
    { grid.sync(); const unsigned long long* t = (const unsigned long long*)(p.ws + WS_TS); const float us = (float)(long long)((t[PROBE_B] - t[PROBE_A]) + (t[PROBE_D] - t[PROBE_C])) * 0.01f; const float sc = 1.f + sqrtf((us + PROBE_CONST) * 1e-8f);
      f32x4* o4 = (f32x4*)p.out; for (size_t i = (size_t)blockIdx.x * 512 + threadIdx.x; i < (size_t)T_ALL * DM / 4; i += (size_t)gridDim.x * 512) o4[i] = o4[i] * sc; }
#else
    PHASE(11, final_norm_phase(p);)
#endif
}

extern "C" void kernel_launch(void* const* d_in, const int* in_sizes, int n_in, void* d_out, int out_size, void* d_ws, size_t ws_size, hipStream_t stream) {
    static int grid_blocks = 0;
    if (!grid_blocks) {
        if (n_in != 24 || ws_size < WS_FCT + 65536) { fprintf(stderr, "kernel_launch: unexpected n_in %d / ws %zu (need %zu)\n", n_in, ws_size, (size_t)WS_END); return; }
        int dev = 0, cus = 0, per_cu = 0;
        hipGetDevice(&dev);
        hipDeviceGetAttribute(&cus, hipDeviceAttributeMultiprocessorCount, dev);
        if (hipFuncSetAttribute((const void*)mega, hipFuncAttributeMaxDynamicSharedMemorySize, LDS_BYTES) != hipSuccess) { fprintf(stderr, "kernel_launch: hipFuncSetAttribute failed\n"); return; }
        hipOccupancyMaxActiveBlocksPerMultiprocessor(&per_cu, mega, 512, LDS_BYTES);
        if (per_cu < 1) { fprintf(stderr, "kernel_launch: occupancy query returned %d\n", per_cu); per_cu = 1; }
        grid_blocks = cus;
    }
    Params p{};
    const float** pp = (const float**)&p;
    for (int i = 0; i < 24; ++i) pp[i] = (const float*)d_in[i];
    p.out = (float*)d_out; p.ws = (unsigned char*)d_ws;
#if ONE_LAUNCH
    p.ph_lo = 0; p.ph_hi = NPHASE;
    void* args[] = {&p};
    hipError_t e = hipLaunchCooperativeKernel((const void*)mega, dim3(grid_blocks), dim3(512), args, LDS_BYTES, stream);
    if (e != hipSuccess) fprintf(stderr, "cooperative launch failed: %s (grid %d)\n", hipGetErrorString(e), grid_blocks);
#else
    for (int ph = 0; ph < NPHASE; ++ph) { p.ph_lo = ph; p.ph_hi = ph + 1; hipLaunchKernelGGL(mega, dim3(grid_blocks), dim3(512), LDS_BYTES, stream, p); }
#endif
}
```
